# Optimizing an MI355X kernel written in HIP

```python
import math
import jax, jax.numpy as jnp
from jax import lax
import numpy as np

D_MODEL = 2048
BATCH = 4
SEQ = 2048
DEPTH = 2

HEAD_DIM = 64
N_HEADS = D_MODEL // 128
N_KV = 4
HPG = N_HEADS // N_KV
NSA_W = N_HEADS * HEAD_DIM
KV_W = N_KV * HEAD_DIM
CMP_BLOCK = 32
CMP_STRIDE = 16
CMP_HIDDEN = 256
SEL_BLOCK = 64
N_SEL = 16
WINDOW = 512
Q_BLOCK = 128
SEL_Q_BLOCK = 64
GM_W = D_MODEL // 2
GM_CHUNK = 128
GM_GW = 128
GM_GROUPS = GM_W // GM_GW
N_BUCKETS = 32
MAX_DISTANCE = 128
D_FF = 5504
EPS = 1e-6
NEG = -1e30
FORCE = 1e4
OFF_KV = NSA_W
OFF_NG = OFF_KV + 6 * KV_W
OFF_UV = OFF_NG + 3 * N_HEADS
OFF_MG = OFF_UV + 2 * GM_W
IN_W = OFF_MG + 2 * D_MODEL

kernel_name = "hybrid_nsa_gmlp_macaron_block"


def rms_norm(x, g):
    x32 = x.astype(jnp.float32)
    y = x32 * lax.rsqrt(jnp.mean(x32 * x32, axis=-1, keepdims=True) + EPS)
    return (y * g.astype(jnp.float32)).astype(x.dtype)


def layer_norm(x, g, b):
    x32 = x.astype(jnp.float32)
    mu = jnp.mean(x32, axis=-1, keepdims=True)
    xc = x32 - mu
    y = xc * lax.rsqrt(jnp.mean(xc * xc, axis=-1, keepdims=True) + EPS)
    return (y * g.astype(jnp.float32) + b.astype(jnp.float32)).astype(x.dtype)


def swiglu(x, w_gate, w_up, w_down):
    return (jax.nn.silu(x @ w_gate) * (x @ w_up)) @ w_down


def t5_bucket(dist):
    n = jnp.maximum(dist, 0)
    max_exact = N_BUCKETS // 2
    nf = jnp.maximum(n, 1).astype(jnp.float32)
    large = max_exact + (jnp.log(nf / max_exact) / math.log(MAX_DISTANCE / max_exact)
                         * (N_BUCKETS - max_exact)).astype(jnp.int32)
    large = jnp.minimum(large, N_BUCKETS - 1)
    return jnp.where(n < max_exact, n, large)


def masked_softmax(logits, bias, mask):
    s = jnp.where(mask, logits.astype(jnp.float32) + bias.astype(jnp.float32), NEG)
    return jax.nn.softmax(s, axis=-1) * mask


def compress(kv, pos, w1, w2):
    B, S, G, D = kv.shape
    n_c = (S - CMP_BLOCK) // CMP_STRIDE + 1
    idx = jnp.arange(n_c)[:, None] * CMP_STRIDE + jnp.arange(CMP_BLOCK)[None, :]
    blocks = kv[:, idx] + pos[:, None, :]
    flat = blocks.transpose(0, 1, 3, 2, 4).reshape(B, n_c, G, CMP_BLOCK * D)
    return jax.nn.silu(flat @ w1) @ w2


def nsa_attention(q, k_c, v_c, k_s, v_s, k_w, v_w, gates, k_norm,
                  cmp_pos_k, cmp_pos_v, cmp_k_w1, cmp_k_w2, cmp_v_w1, cmp_v_w2, rel_bias):
    B, S = q.shape[:2]
    scale = HEAD_DIM ** -0.5
    t = jnp.arange(S)

    kc = rms_norm(compress(k_c, cmp_pos_k, cmp_k_w1, cmp_k_w2), k_norm[0])
    vc = compress(v_c, cmp_pos_v, cmp_v_w1, cmp_v_w2)
    n_c = kc.shape[1]
    c_end = jnp.arange(n_c) * CMP_STRIDE + CMP_BLOCK - 1
    dist_c = t[:, None] - c_end[None, :]
    bias_c = rel_bias[t5_bucket(dist_c)].reshape(S, n_c, N_KV, HPG).transpose(2, 3, 0, 1)
    logits_c = jnp.einsum('bsghd,bcgd->bghsc', q, kc) * scale
    p_c = masked_softmax(logits_c, bias_c, dist_c >= 0)
    o_c = jnp.einsum('bghsc,bcgd->bsghd', p_c.astype(vc.dtype), vc)

    n_s = S // SEL_BLOCK
    ci = jnp.arange(n_c)[:, None] * CMP_STRIDE
    sj = jnp.arange(n_s)[None, :] * SEL_BLOCK
    overlap = jnp.clip(jnp.minimum(ci + CMP_BLOCK, sj + SEL_BLOCK) - jnp.maximum(ci, sj), 0, None)
    overlap = overlap.astype(jnp.float32) / CMP_BLOCK
    imp = jnp.einsum('bghsc,cj->bgsj', p_c, overlap)
    blk = jnp.arange(n_s)[None, :]
    cur = (t // SEL_BLOCK)[:, None]
    forced = (blk == 0) | (blk == cur) | (blk == cur - 1)
    score = jnp.where(blk <= cur, jnp.where(forced, FORCE, imp), NEG)
    n_sel = min(N_SEL, n_s)
    _, sel_idx = lax.top_k(score, n_sel)
    sel_ok = sel_idx <= cur

    k_s_t = k_s.transpose(0, 2, 1, 3)
    v_s_t = v_s.transpose(0, 2, 1, 3)
    tbl = rel_bias.reshape(N_BUCKETS, N_KV, HPG).transpose(1, 0, 2)
    n_qb = S // SEL_Q_BLOCK
    bi = jnp.arange(B)[:, None, None, None]
    gi = jnp.arange(N_KV)[None, :, None, None]
    offs = jnp.arange(SEL_BLOCK)

    def sel_block(args):
        qb, ib, okb, tb = args
        tok = (ib[..., None] * SEL_BLOCK + offs).reshape(B, N_KV, SEL_Q_BLOCK, n_sel * SEL_BLOCK)
        kg = k_s_t[bi, gi, tok]
        vg = v_s_t[bi, gi, tok]
        dist = tb[None, None, :, None] - tok
        bias = tbl[gi, t5_bucket(dist)].transpose(0, 1, 4, 2, 3)
        mask = (dist >= 0) & jnp.repeat(okb, SEL_BLOCK, axis=-1)
        logits = jnp.einsum('bqghd,bgqkd->bghqk', qb, kg) * scale
        p = masked_softmax(logits, bias, mask[:, :, None])
        return jnp.einsum('bghqk,bgqkd->bqghd', p.astype(vg.dtype), vg)

    qs = q.reshape(B, n_qb, SEL_Q_BLOCK, N_KV, HPG, HEAD_DIM).swapaxes(0, 1)
    is_ = sel_idx.reshape(B, N_KV, n_qb, SEL_Q_BLOCK, n_sel).transpose(2, 0, 1, 3, 4)
    oks = sel_ok.reshape(B, N_KV, n_qb, SEL_Q_BLOCK, n_sel).transpose(2, 0, 1, 3, 4)
    ts = t.reshape(n_qb, SEL_Q_BLOCK)
    o_s = lax.map(sel_block, (qs, is_, oks, ts))
    o_s = o_s.swapaxes(0, 1).reshape(B, S, N_KV, HPG, HEAD_DIM)

    nb = S // Q_BLOCK
    span = WINDOW + Q_BLOCK
    pad = ((0, 0), (WINDOW, 0), (0, 0), (0, 0))
    widx = jnp.arange(nb)[:, None] * Q_BLOCK + jnp.arange(span)[None, :]
    kb = jnp.pad(k_w, pad)[:, widx]
    vb = jnp.pad(v_w, pad)[:, widx]
    qpos = t.reshape(nb, Q_BLOCK)
    kpos = widx - WINDOW
    dist_w = qpos[:, :, None] - kpos[:, None, :]
    mask_w = (dist_w >= 0) & (dist_w < WINDOW) & (kpos[:, None, :] >= 0)
    bias_w = rel_bias[t5_bucket(dist_w)].reshape(nb, Q_BLOCK, span, N_KV, HPG).transpose(0, 3, 4, 1, 2)
    logits_w = jnp.einsum('bnqghd,bnkgd->bnghqk',
                          q.reshape(B, nb, Q_BLOCK, N_KV, HPG, HEAD_DIM), kb) * scale
    p_w = masked_softmax(logits_w, bias_w, mask_w[:, None, None])
    o_w = jnp.einsum('bnghqk,bnkgd->bnqghd', p_w.astype(vb.dtype), vb).reshape(B, S, N_KV, HPG, HEAD_DIM)

    return gates[..., 0:1] * o_c + gates[..., 1:2] * o_s + gates[..., 2:3] * o_w


def spatial_gating(uv, g, b, w_s, b_s):
    B, S, _ = uv.shape
    u, v = uv[..., :GM_W], uv[..., GM_W:]
    v = layer_norm(v, g, b).reshape(B, S // GM_CHUNK, GM_CHUNK, GM_GROUPS, GM_GW)
    causal = jnp.tril(jnp.ones((GM_CHUNK, GM_CHUNK), w_s.dtype))
    mixed = jnp.einsum('gts,bcsgd->bctgd', w_s * causal, v) + b_s.T[:, :, None]
    return u * mixed.reshape(B, S, GM_W)


def mixer_block(x, mix_norm, w_in, q_norm, k_norm, cmp_pos_k, cmp_pos_v, cmp_k_w1, cmp_k_w2,
                cmp_v_w1, cmp_v_w2, sgu_norm_g, sgu_norm_b, sgu_w, sgu_b,
                w_proj_nsa, w_proj_sgu, w_out, rel_bias):
    B, S, _ = x.shape
    h = rms_norm(x, mix_norm)
    z = h @ w_in
    q = rms_norm(z[..., :OFF_KV].reshape(B, S, N_KV, HPG, HEAD_DIM), q_norm)
    kv = z[..., OFF_KV:OFF_NG].reshape(B, S, 6, N_KV, HEAD_DIM)
    k_s = rms_norm(kv[:, :, 2], k_norm[1])
    k_w = rms_norm(kv[:, :, 4], k_norm[2])
    gates = jax.nn.sigmoid(z[..., OFF_NG:OFF_UV]).reshape(B, S, N_KV, HPG, 3)
    a = nsa_attention(q, kv[:, :, 0], kv[:, :, 1], k_s, kv[:, :, 3], k_w, kv[:, :, 5], gates, k_norm,
                      cmp_pos_k, cmp_pos_v, cmp_k_w1, cmp_k_w2, cmp_v_w1, cmp_v_w2,
                      rel_bias).reshape(B, S, NSA_W)
    sg = spatial_gating(jax.nn.gelu(z[..., OFF_UV:OFF_MG]), sgu_norm_g, sgu_norm_b, sgu_w, sgu_b)
    mg = jax.nn.sigmoid(z[..., OFF_MG:])
    merged = mg[..., :D_MODEL] * (a @ w_proj_nsa) + mg[..., D_MODEL:] * (sg @ w_proj_sgu)
    return merged @ w_out


def setup_inputs(seed: int = 0) -> dict:
    key = jax.random.key(seed)
    ks = jax.random.split(key, 32)
    f32 = jnp.float32
    L = DEPTH

    def nrm(k, shape, fan_in):
        return jax.random.normal(k, shape, f32) * (fan_in ** -0.5)

    def gain(k, shape):
        return 1.0 + 0.05 * jax.random.normal(k, shape, f32)

    return {
        "x": jax.random.normal(ks[0], (BATCH, SEQ, D_MODEL), f32),
        "rel_bias": 0.5 * jax.random.normal(ks[1], (N_BUCKETS, N_HEADS), f32),
        "ffn1_norm": gain(ks[2], (L, D_MODEL)),
        "ffn1_w_gate": nrm(ks[3], (L, D_MODEL, D_FF), D_MODEL),
        "ffn1_w_up": nrm(ks[4], (L, D_MODEL, D_FF), D_MODEL),
        "ffn1_w_down": nrm(ks[5], (L, D_FF, D_MODEL), D_FF),
        "mix_norm": gain(ks[6], (L, D_MODEL)),
        "w_in": nrm(ks[7], (L, D_MODEL, IN_W), D_MODEL),
        "q_norm": gain(ks[8], (L, HEAD_DIM)),
        "k_norm": gain(ks[9], (L, 3, HEAD_DIM)),
        "cmp_pos_k": 0.5 * jax.random.normal(ks[10], (L, CMP_BLOCK, HEAD_DIM), f32),
        "cmp_pos_v": 0.5 * jax.random.normal(ks[11], (L, CMP_BLOCK, HEAD_DIM), f32),
        "cmp_k_w1": nrm(ks[12], (L, CMP_BLOCK * HEAD_DIM, CMP_HIDDEN), CMP_BLOCK * HEAD_DIM),
        "cmp_k_w2": nrm(ks[13], (L, CMP_HIDDEN, HEAD_DIM), CMP_HIDDEN),
        "cmp_v_w1": nrm(ks[14], (L, CMP_BLOCK * HEAD_DIM, CMP_HIDDEN), CMP_BLOCK * HEAD_DIM),
        "cmp_v_w2": nrm(ks[15], (L, CMP_HIDDEN, HEAD_DIM), CMP_HIDDEN),
        "sgu_norm_g": gain(ks[16], (L, GM_W)),
        "sgu_norm_b": 0.02 * jax.random.normal(ks[17], (L, GM_W), f32),
        "sgu_w": nrm(ks[18], (L, GM_GROUPS, GM_CHUNK, GM_CHUNK), GM_CHUNK),
        "sgu_b": 1.0 + 0.1 * jax.random.normal(ks[19], (L, GM_GROUPS, GM_CHUNK), f32),
        "w_proj_nsa": nrm(ks[20], (L, NSA_W, D_MODEL), NSA_W),
        "w_proj_sgu": nrm(ks[21], (L, GM_W, D_MODEL), GM_W),
        "w_out": nrm(ks[22], (L, D_MODEL, D_MODEL), D_MODEL),
        "ffn2_norm": gain(ks[23], (L, D_MODEL)),
        "ffn2_w_gate": nrm(ks[24], (L, D_MODEL, D_FF), D_MODEL),
        "ffn2_w_up": nrm(ks[25], (L, D_MODEL, D_FF), D_MODEL),
        "ffn2_w_down": nrm(ks[26], (L, D_FF, D_MODEL), D_FF),
    }


def reference(x, rel_bias, ffn1_norm, ffn1_w_gate, ffn1_w_up, ffn1_w_down, mix_norm, w_in,
              q_norm, k_norm, cmp_pos_k, cmp_pos_v, cmp_k_w1, cmp_k_w2, cmp_v_w1, cmp_v_w2,
              sgu_norm_g, sgu_norm_b, sgu_w, sgu_b, w_proj_nsa, w_proj_sgu, w_out,
              ffn2_norm, ffn2_w_gate, ffn2_w_up, ffn2_w_down):
    for l in range(DEPTH):
        x = x + 0.5 * swiglu(rms_norm(x, ffn1_norm[l]), ffn1_w_gate[l], ffn1_w_up[l], ffn1_w_down[l])
        x = x + mixer_block(x, mix_norm[l], w_in[l], q_norm[l], k_norm[l], cmp_pos_k[l], cmp_pos_v[l],
                            cmp_k_w1[l], cmp_k_w2[l], cmp_v_w1[l], cmp_v_w2[l],
                            sgu_norm_g[l], sgu_norm_b[l], sgu_w[l], sgu_b[l],
                            w_proj_nsa[l], w_proj_sgu[l], w_out[l], rel_bias)
        x = x + 0.5 * swiglu(rms_norm(x, ffn2_norm[l]), ffn2_w_gate[l], ffn2_w_up[l], ffn2_w_down[l])
    return x
```

```cpp
#include <hip/hip_runtime.h>
#include <hip/hip_cooperative_groups.h>
#include <cstdio>
#include <cstdint>
namespace cg = cooperative_groups;
namespace pg8 {
#define PG8_LAS __attribute__((address_space(3)))
typedef unsigned short bf16_t;
typedef short bf16x8 __attribute__((ext_vector_type(8)));
typedef float f32x4 __attribute__((ext_vector_type(4)));
typedef unsigned u32x4 __attribute__((ext_vector_type(4)));
constexpr int BM = 256, BK = 64, HALF = 128, HTB = HALF * BK * 2  , STAGE_BYTES = 8 * HTB, NXCD = 8, WGM = 4;

__host__ __device__ __forceinline__ int lds_byte(int r, int c) { const int st = (r >> 4) * 2 + (c >> 5), rr = r & 15, cc = c & 31, ob = rr * 64 + cc * 2; return st * 1024 + (ob ^ (((ob >> 9) & 1) << 5)); }
__host__ __device__ __forceinline__ void stage_rc(int b, int& R, int& C) { const int st = b / 1024, sb = b % 1024, swz = sb ^ (((sb >> 9) & 1) << 5); R = (st >> 1) * 16 + swz / 64; C = (st & 1) * 32 + (swz % 64) / 2; }
__host__ __device__ __forceinline__ int perm32(int rho) { const int n = rho >> 4, i = rho & 15; return 8 * (i >> 2) + 4 * n + (i & 3); }

struct Unit { int pm, pn, kind; };
struct Gemm { const bf16_t* A; const bf16_t* Bt; int M, N, K, ld; const bf16_t* A2; const bf16_t* Bt2; };

struct StaticOrder {
    int nM, nN, nwg, G, c, lim;
    __host__ __device__ __forceinline__ void init(int M, int N, int G_, int c_) { nM = M / BM; nN = N / BM; nwg = nM * nN; G = G_; c = c_; lim = nwg; }
    __host__ __device__ __forceinline__ bool next(int i, Unit& u) const {
        const long L = (long)i * G + c; if (L >= lim) return false;
        tile_of((int)L, u); return true;
    }
    __host__ __device__ __forceinline__ void tile_of(int L_, Unit& u) const {
        const long L = L_;
        int wgid = (int)L; { const int q = nwg / NXCD, r = nwg % NXCD, xcd = wgid % NXCD, off = wgid / NXCD; wgid = (xcd < r ? xcd * (q + 1) : r * (q + 1) + (xcd - r) * q) + off; }
        const int nig = WGM * nN, gid = wgid / nig, fm = gid * WGM, gsz = (nM - fm) < WGM ? (nM - fm) : WGM;
        u.pm = fm + ((wgid % nig) % gsz); u.pn = (wgid % nig) / gsz; u.kind = 0;
    }
    __device__ __forceinline__ void a_ready(const Unit&) const {}
    __device__ __forceinline__ void done(const Unit&) const {}
};
struct TwoKinds {
    StaticOrder so;
    __device__ __forceinline__ bool next(int i, Unit& u) const { if (!so.next(i >> 1, u)) return false; u.kind = i & 1; return true; }
    __device__ __forceinline__ void a_ready(const Unit&) const {}
    __device__ __forceinline__ void done(const Unit&) const {}
};
struct OneUnit {
    Unit u0;
    __device__ __forceinline__ bool next(int i, Unit& u) const { if (i != 0) return false; u = u0; return true; }
    __device__ __forceinline__ void a_ready(const Unit&) const {}
    __device__ __forceinline__ void done(const Unit&) const {}
};

__device__ __forceinline__ unsigned cvt_pk_bf16(float lo, float hi) { unsigned r; asm volatile("v_cvt_pk_bf16_f32 %0, %1, %2" : "=v"(r) : "v"(lo), "v"(hi)); return r; }
typedef float f32x2 __attribute__((ext_vector_type(2)));
template <class Epi, class Sched, bool ALIGN_EPI = false, bool SP2 = false>
__device__ __forceinline__ void gemm_phase(PG8_LAS unsigned char* lds, const Gemm g, const Sched& S, const Epi& E) {
    int tid_ = threadIdx.x; asm volatile("" : "+v"(tid_)); const int tid = tid_, wid = __builtin_amdgcn_readfirstlane(tid >> 6), lane = tid & 63, wr = wid >> 2, wc = wid & 3, fr = lane & 15, fq = lane >> 4;
    const int K = g.ld, nt = g.K / BK;
    unsigned voffA[2], voffB[2];
#pragma unroll
    for (int i = 0; i < 2; ++i) { int R, C; stage_rc(tid * 16 + i * 8192, R, C); const int Rb = Epi::PERM ? ((R & ~31) + perm32(R & 31)) : R;
        voffA[i] = (unsigned)(R * K + C) * 2u; voffB[i] = (unsigned)(Rb * K + C) * 2u; }
    const size_t kstep = (size_t)(BK * 2);
    const size_t hstep = (size_t)HALF * K * 2;
    const size_t tstep = 2 * hstep;
    const unsigned ldsw = (unsigned)wid * 1024u;
    const int aoff = lds_byte(wr * 64 + fr, fq * 8), boff = lds_byte(wc * 32 + fr, fq * 8);
#define PG8_SA(b, h) (((b) * 2 + (h)) * HTB)
#define PG8_SB(b, h) ((4 + (b) * 2 + (h)) * HTB)
#define PG8_STAGE(bufoff, gbase, voff) do { _Pragma("unroll") for (int _i = 0; _i < 2; ++_i) \
        __builtin_amdgcn_global_load_lds((const unsigned*)((const char*)(gbase) + (voff)[_i]), (PG8_LAS unsigned*)(lds + (bufoff) + ldsw + _i * 8192), 16, 0, 0); } while (0)
#define PG8_LDA(dst, b, h) do { _Pragma("unroll") for (int m = 0; m < 4; ++m) _Pragma("unroll") for (int k = 0; k < 2; ++k) dst[m][k] = *(const PG8_LAS bf16x8*)(lds + PG8_SA(b, h) + aoff + m * 2048 + k * 1024); } while (0)
#define PG8_LDB(dst, b, h) do { _Pragma("unroll") for (int n = 0; n < 2; ++n) _Pragma("unroll") for (int k = 0; k < 2; ++k) dst[n][k] = *(const PG8_LAS bf16x8*)(lds + PG8_SB(b, h) + boff + n * 2048 + k * 1024); } while (0)
#define PG8_MMA(ai, bj, At, Bt) do { __builtin_amdgcn_s_setprio(1); _Pragma("unroll") for (int m = 0; m < 4; ++m) _Pragma("unroll") for (int n = 0; n < 2; ++n) _Pragma("unroll") for (int k = 0; k < 2; ++k) \
        acc[ai][bj][m][n] = __builtin_amdgcn_mfma_f32_16x16x32_bf16(Bt[n][k], At[m][k], acc[ai][bj][m][n], 0, 0, 0); __builtin_amdgcn_s_setprio(0); } while (0)
#define PG8_WAIT_V(n) asm volatile("s_waitcnt vmcnt(" #n ")" ::: "memory")
#define PG8_WAIT_L(n) asm volatile("s_waitcnt lgkmcnt(" #n ")" ::: "memory")
#define PG8_BAR __builtin_amdgcn_s_barrier()
#define PG8_SCHED __builtin_amdgcn_sched_barrier(0)
    Unit cur, nxt; int ui = 0;
    if (!S.next(0, cur)) return;
    f32x4 acc[2][2][4][2];
#pragma unroll
    for (int a = 0; a < 2; ++a)
#pragma unroll
        for (int b = 0; b < 2; ++b)
#pragma unroll
            for (int m = 0; m < 4; ++m)
#pragma unroll
                for (int n = 0; n < 2; ++n) acc[a][b][m][n] = (f32x4){0.f, 0.f, 0.f, 0.f};
    bf16x8 At[4][2], B0[2][2], B1[2][2];
    const char* cA = (const char*)(cur.kind ? g.A2 : g.A) + (size_t)cur.pm * tstep; const char* cB = (const char*)(cur.kind ? g.Bt2 : g.Bt) + (size_t)cur.pn * tstep;
    S.a_ready(cur);
    if constexpr (SP2) {
        PG8_STAGE(PG8_SB(0, 0), cB, voffB); PG8_STAGE(PG8_SB(0, 1), cB + hstep, voffB); PG8_STAGE(PG8_SA(0, 0), cA, voffA); PG8_STAGE(PG8_SA(0, 1), cA + hstep, voffA);
        if (wr == 1) PG8_BAR;
        PG8_WAIT_V(2); PG8_BAR;
        PG8_STAGE(PG8_SB(1, 0), cB + kstep, voffB); PG8_STAGE(PG8_SA(1, 0), cA + kstep, voffA); PG8_STAGE(PG8_SB(1, 1), cB + hstep + kstep, voffB);
        PG8_WAIT_V(6); PG8_BAR;
    } else {
        PG8_STAGE(PG8_SB(0, 0), cB, voffB); PG8_STAGE(PG8_SA(0, 0), cA, voffA); PG8_STAGE(PG8_SB(0, 1), cB + hstep, voffB); PG8_STAGE(PG8_SA(0, 1), cA + hstep, voffA);
        if (wr == 1) PG8_BAR;
        PG8_WAIT_V(4); PG8_BAR;
        PG8_STAGE(PG8_SB(1, 0), cB + kstep, voffB); PG8_STAGE(PG8_SA(1, 0), cA + kstep, voffA); PG8_STAGE(PG8_SB(1, 1), cB + hstep + kstep, voffB);
        PG8_WAIT_V(6); PG8_BAR;
    }
    for (;;) {
        const bool has_next = S.next(ui + 1, nxt);
        const char* nA = has_next ? (const char*)(nxt.kind ? g.A2 : g.A) + (size_t)nxt.pm * tstep : cA; const char* nB = has_next ? (const char*)(nxt.kind ? g.Bt2 : g.Bt) + (size_t)nxt.pn * tstep : cB;
        for (int t = 0; t < nt; t += 2) {
            const bool last = (t == nt - 2);
            const char* a1 = cA + (size_t)(t + 1) * kstep;
            const char* a2 = last ? nA : cA + (size_t)(t + 2) * kstep; const char* b2 = last ? nB : cB + (size_t)(t + 2) * kstep;
            const char* a3 = a2 + kstep; const char* b3 = b2 + kstep;
            if (last && has_next) S.a_ready(nxt);
            if constexpr (SP2) {
            PG8_LDB(B0, 0, 0); PG8_LDB(B1, 0, 1); PG8_SCHED; PG8_LDA(At, 0, 0); PG8_STAGE(PG8_SA(1, 1), a1 + hstep, voffA);
            PG8_WAIT_V(8); PG8_WAIT_L(0); PG8_BAR; PG8_MMA(0, 0, At, B0); PG8_MMA(0, 1, At, B1); PG8_BAR; PG8_SCHED;
            PG8_LDA(At, 0, 1); PG8_STAGE(PG8_SB(0, 0), b2, voffB); PG8_STAGE(PG8_SB(0, 1), b2 + hstep, voffB); PG8_STAGE(PG8_SA(0, 0), a2, voffA);
            PG8_WAIT_V(8); PG8_WAIT_L(0); PG8_BAR; PG8_MMA(1, 0, At, B0); PG8_MMA(1, 1, At, B1); PG8_BAR; PG8_SCHED;
            PG8_LDB(B0, 1, 0); PG8_LDB(B1, 1, 1); PG8_SCHED; PG8_LDA(At, 1, 0); PG8_STAGE(PG8_SA(0, 1), a2 + hstep, voffA);
            PG8_WAIT_V(8); PG8_WAIT_L(0); PG8_BAR; PG8_MMA(0, 0, At, B0); PG8_MMA(0, 1, At, B1); PG8_BAR; PG8_SCHED;
            PG8_LDA(At, 1, 1); PG8_STAGE(PG8_SB(1, 0), b3, voffB); PG8_STAGE(PG8_SB(1, 1), b3 + hstep, voffB); PG8_STAGE(PG8_SA(1, 0), a3, voffA);
            PG8_WAIT_V(8); PG8_WAIT_L(0); PG8_BAR; PG8_MMA(1, 0, At, B0); PG8_MMA(1, 1, At, B1); PG8_BAR; PG8_SCHED;
            } else {
            PG8_LDB(B0, 0, 0); PG8_SCHED; PG8_LDA(At, 0, 0); PG8_STAGE(PG8_SA(1, 1), a1 + hstep, voffA);
            PG8_WAIT_L(8); PG8_BAR; PG8_WAIT_L(0); PG8_MMA(0, 0, At, B0); PG8_BAR; PG8_SCHED;
            PG8_LDB(B1, 0, 1); PG8_STAGE(PG8_SB(0, 0), b2, voffB);
            PG8_BAR; PG8_WAIT_L(0); PG8_MMA(0, 1, At, B1); PG8_BAR;
            PG8_LDA(At, 0, 1); PG8_STAGE(PG8_SA(0, 0), a2, voffA);
            PG8_BAR; PG8_WAIT_L(0); PG8_MMA(1, 0, At, B0); PG8_BAR; PG8_SCHED;
            PG8_STAGE(PG8_SB(0, 1), b2 + hstep, voffB);
            PG8_WAIT_V(6); PG8_BAR; PG8_MMA(1, 1, At, B1); PG8_BAR;
            PG8_LDB(B0, 1, 0); PG8_SCHED; PG8_LDA(At, 1, 0); PG8_STAGE(PG8_SA(0, 1), a2 + hstep, voffA);
            PG8_WAIT_L(8); PG8_BAR; PG8_WAIT_L(0); PG8_MMA(0, 0, At, B0); PG8_BAR; PG8_SCHED;
            PG8_LDB(B1, 1, 1); PG8_STAGE(PG8_SB(1, 0), b3, voffB);
            PG8_BAR; PG8_WAIT_L(0); PG8_MMA(0, 1, At, B1); PG8_BAR;
            PG8_LDA(At, 1, 1); PG8_STAGE(PG8_SA(1, 0), a3, voffA);
            PG8_BAR; PG8_WAIT_L(0); PG8_MMA(1, 0, At, B0); PG8_BAR; PG8_SCHED;
            PG8_STAGE(PG8_SB(1, 1), b3 + hstep, voffB);
            PG8_WAIT_V(6); PG8_BAR; PG8_MMA(1, 1, At, B1); PG8_BAR;
            }
        }
        if constexpr (ALIGN_EPI) { if (wr == 0) PG8_BAR; }
        if constexpr (!Epi::AFTER_DRAIN) { E(acc, cur, wr, wc, fr, fq); S.done(cur); }
        if (!has_next) break;
#pragma unroll
        for (int a = 0; a < 2; ++a)
#pragma unroll
            for (int b = 0; b < 2; ++b)
#pragma unroll
                for (int m = 0; m < 4; ++m)
#pragma unroll
                    for (int n = 0; n < 2; ++n) acc[a][b][m][n] = (f32x4){0.f, 0.f, 0.f, 0.f};
        cur = nxt; cA = nA; cB = nB; ++ui;
        if constexpr (ALIGN_EPI) { if (wr == 1) PG8_BAR; }
    }
    PG8_WAIT_V(0);
    if constexpr (!ALIGN_EPI) { if (wr == 0) PG8_BAR; }
    PG8_BAR;
    if constexpr (Epi::AFTER_DRAIN) { E.fused(acc, cur, wr, wc, fr, fq, lds, wid, lane); S.done(cur); }
#undef PG8_SA
#undef PG8_SB
#undef PG8_STAGE
#undef PG8_LDA
#undef PG8_LDB
#undef PG8_MMA
#undef PG8_WAIT_V
#undef PG8_WAIT_L
#undef PG8_BAR
#undef PG8_SCHED
}
}

constexpr int NB = 4, S = 2048, D = 2048, M = NB * S, FF = 5504, INW = 8752, INP = 8960, NLAYER = 2;
constexpr float EPS = 1e-6f, NEGF = -1e30f;
typedef unsigned short bf16;
typedef short bf16x8 __attribute__((ext_vector_type(8)));
typedef short s16x4 __attribute__((ext_vector_type(4)));
typedef float f32x4 __attribute__((ext_vector_type(4)));
typedef unsigned u32x4 __attribute__((ext_vector_type(4)));
typedef unsigned u32x2 __attribute__((ext_vector_type(2)));
#define LAS __attribute__((address_space(3)))

constexpr size_t AL(size_t x) { return (x + 255) & ~(size_t)255; }
constexpr size_t LW_GU1 = 0;
constexpr size_t LW_D1 = LW_GU1 + AL((size_t)2 * FF * D * 2);
constexpr size_t LW_IN = LW_D1 + AL((size_t)D * FF * 2);
constexpr size_t LW_PN = LW_IN + AL((size_t)INP * D * 2);
constexpr size_t LW_PS = LW_PN + AL((size_t)D * 1024 * 2);
constexpr size_t LW_O = LW_PS + AL((size_t)D * 1024 * 2);
constexpr size_t LW_GU2 = LW_O + AL((size_t)D * D * 2);
constexpr size_t LW_D2 = LW_GU2 + AL((size_t)2 * FF * D * 2);
constexpr size_t LW_C1K = LW_D2 + AL((size_t)D * FF * 2);
constexpr size_t LW_C1V = LW_C1K + AL((size_t)256 * 2048 * 2);
constexpr size_t LW_C2K = LW_C1V + AL((size_t)256 * 2048 * 2);
constexpr size_t LW_C2V = LW_C2K + AL((size_t)64 * 256 * 2);
constexpr size_t LW_SGW = LW_C2V + AL((size_t)64 * 256 * 2);
constexpr size_t LW_B1 = LW_SGW + AL((size_t)8 * 128 * 128 * 2);
constexpr size_t LW_PAR = LW_B1 + AL((size_t)2 * 256 * 4);
constexpr int PAR_QN = 0, PAR_KN = 64, PAR_SGG = 256, PAR_SGB = 1280, PAR_SGBS = 2304, PAR_N1 = 3328, PAR_NM = 5376, PAR_N2 = 7424, PAR_RELB = 9472, PAR_FLOATS = 9984;
constexpr size_t LW_BYTES = LW_PAR + AL((size_t)PAR_FLOATS * 4);
constexpr size_t WS_H = NLAYER * LW_BYTES;
constexpr size_t WS_X = WS_H + AL((size_t)M * D * 2);
constexpr size_t WS_HFF = WS_X;
constexpr size_t KV_ELEMS = (size_t)16 * 2048 * 64;
constexpr size_t WS_Q = WS_X;
constexpr size_t WS_KV = WS_Q + AL((size_t)M * 1024 * 2);
constexpr size_t WS_U = WS_KV + 6 * KV_ELEMS * 2 + 8192;
constexpr size_t WS_V = WS_U + AL((size_t)M * 1024 * 2);
constexpr size_t WS_MG = WS_V + AL((size_t)M * 1024 * 2);
constexpr size_t WS_GATES = WS_MG + AL((size_t)M * 4096 * 2);
constexpr size_t WS_VSTAT = WS_GATES + AL((size_t)M * 48 * 4);
constexpr size_t WS_KCN = WS_VSTAT + AL((size_t)M * 32 * 4);
constexpr size_t WS_VCT = WS_KCN + AL((size_t)16 * 128 * 64 * 2);
constexpr size_t WS_SG = WS_VCT + AL((size_t)16 * 128 * 64 * 2);
constexpr size_t WS_A = WS_SG + AL((size_t)M * 1024 * 2);
constexpr size_t WS_T = WS_A + AL((size_t)M * 1024 * 2);
constexpr size_t WS_MRG = WS_T + AL((size_t)M * D * 2);
constexpr size_t WS_END_A = WS_MRG + AL((size_t)M * D * 2);
constexpr size_t WS_END_B = WS_HFF + AL((size_t)M * FF * 2);
constexpr size_t WS_BAR = WS_END_A > WS_END_B ? WS_END_A : WS_END_B;
constexpr int BARW_TOTAL = 8192, CNT_W0 = 4096;
constexpr size_t WS_SS = WS_BAR + (size_t)BARW_TOTAL * 4;
constexpr size_t WS_L = WS_SS + (size_t)M * 8 * 4;
constexpr size_t WS_SLAB = WS_L + (size_t)M * D * 2;
constexpr size_t WS_END = WS_SLAB;

constexpr int LDS_XCH = 131072;
constexpr int LDS_BYTES = 147456;

struct Args { const float* in[27]; float* out; unsigned char* ws; };

__device__ __forceinline__ LAS unsigned char* lds_base() { extern __shared__ __attribute__((aligned(16))) unsigned char lds_any_[]; return (LAS unsigned char*)lds_any_; }
#define OPQ_S(x) asm volatile("" : "+s"(x))
#define OPQ_V(x) asm volatile("" : "+v"(x))
#define GASP __attribute__((address_space(1)))
#define OPQ_P(x) do { unsigned long long t_ = (unsigned long long)(x); asm volatile("" : "+s"(t_)); x = (decltype(x))(GASP unsigned char*)t_; } while (0)
__device__ __forceinline__ unsigned cvtpk(float lo, float hi) {
    typedef float f2 __attribute__((ext_vector_type(2))); typedef __bf16 b2 __attribute__((ext_vector_type(2)));
    f2 v = {lo, hi}; b2 b = __builtin_convertvector(v, b2); return __builtin_bit_cast(unsigned, b);
}
__device__ __forceinline__ bf16 f2bf(float f) { return (bf16)(cvtpk(f, 0.f) & 0xffffu); }
__device__ __forceinline__ float bflo(unsigned w) { return __builtin_bit_cast(float, w << 16); }
__device__ __forceinline__ float bfhi(unsigned w) { return __builtin_bit_cast(float, w & 0xffff0000u); }
__device__ __forceinline__ float sigm(float x) { return __builtin_amdgcn_rcpf(1.f + __expf(-x)); }
__device__ __forceinline__ float siluf_(float x) { return x * sigm(x); }
__device__ __forceinline__ float gelu_tanh(float x) { return x * sigm(1.5957691216f * (x + 0.044715f * x * x * x)); }
__device__ __forceinline__ float wave_sum(float v) {
#pragma unroll
    for (int o = 1; o < 64; o <<= 1) v += __shfl_xor(v, o);
    return v;
}
__device__ __forceinline__ u32x4 pack8(const float* v) { u32x4 w; w.x = cvtpk(v[0], v[1]); w.y = cvtpk(v[2], v[3]); w.z = cvtpk(v[4], v[5]); w.w = cvtpk(v[6], v[7]); return w; }
__device__ __forceinline__ int t5_bucket(int d) {
    if (d < 16) return d;
    int b = 16;
    b += (d >= 19) + (d >= 21) + (d >= 24) + (d >= 27) + (d >= 31) + (d >= 35) + (d >= 40) + (d >= 46) + (d >= 52) + (d >= 59) + (d >= 67) + (d >= 77) + (d >= 87) + (d >= 99) + (d >= 113);
    return b;
}
constexpr int BIAS_N = 114;

#define EPI_HEAD unsigned char* w_ = ws; OPQ_P(w_); int fr_ = fr, fq_ = fq; OPQ_V(fr_); OPQ_V(fq_);
constexpr int LDS_RSC = 135168, LDS_RSTAG = LDS_RSC + 1024;
#define EPI_RSTD(rs_) float rs_[2][4]; { \
    LAS float* rsc_ = (LAS float*)(lds_base() + LDS_RSC); LAS int* tag_ = (LAS int*)(lds_base() + LDS_RSTAG) + (wr * 4 + wc); \
    if (*tag_ == u.pm + 1) { \
        _Pragma("unroll") for (int ai = 0; ai < 2; ++ai) _Pragma("unroll") for (int m = 0; m < 4; ++m) rs_[ai][m] = rsc_[ai * 128 + wr * 64 + m * 16 + fr_]; \
    } else { \
        const float* ss_ = (const float*)(w_ + WS_SS); \
        _Pragma("unroll") for (int ai = 0; ai < 2; ++ai) _Pragma("unroll") for (int m = 0; m < 4; ++m) { \
            const f32x4 a_ = *(const f32x4*)(ss_ + (size_t)(row0 + ai * 128 + m * 16) * 8), b_ = *(const f32x4*)(ss_ + (size_t)(row0 + ai * 128 + m * 16) * 8 + 4); \
            rs_[ai][m] = rsqrtf((((a_.x + a_.y) + (a_.z + a_.w)) + ((b_.x + b_.y) + (b_.z + b_.w))) * (1.f / D) + EPS); \
            rsc_[ai * 128 + wr * 64 + m * 16 + fr_] = rs_[ai][m]; } \
        *tag_ = u.pm + 1; \
    } }
struct EpiSwiGLU {
    static constexpr bool PERM = true, AFTER_DRAIN = false;
    unsigned char* ws;
    __device__ __forceinline__ void operator()(const pg8::f32x4 (&acc)[2][2][4][2], const pg8::Unit& u, int wr, int wc, int fr, int fq) const {
        EPI_HEAD
        bf16* O = (bf16*)(w_ + WS_HFF);
        const int row0 = u.pm * 256 + wr * 64 + fr_, col0 = u.pn * 128 + wc * 32 + fq_ * 8;
        EPI_RSTD(rs)
#pragma unroll
        for (int ai = 0; ai < 2; ++ai)
#pragma unroll
            for (int m = 0; m < 4; ++m) {
                float v[8]; const float r = rs[ai][m];
#pragma unroll
                for (int n = 0; n < 2; ++n)
#pragma unroll
                    for (int j = 0; j < 4; ++j) v[n * 4 + j] = siluf_(acc[ai][0][m][n][j] * r) * (acc[ai][1][m][n][j] * r);
                __builtin_nontemporal_store(pack8(v), (u32x4*)(O + (size_t)(row0 + ai * 128 + m * 16) * FF + col0));
            }
    }
};
struct EpiResid {
    static constexpr bool PERM = true, AFTER_DRAIN = false;
    float* OUT; unsigned char* ws; float scale; int last;
    __device__ __forceinline__ void operator()(const pg8::f32x4 (&acc)[2][2][4][2], const pg8::Unit& u, int wr, int wc, int fr, int fq) const {
        float* x_ = OUT; OPQ_P(x_); EPI_HEAD
        bf16* H = (bf16*)(w_ + WS_H); bf16* L = (bf16*)(w_ + WS_L); LAS float* xch = (LAS float*)(lds_base() + LDS_XCH);
        const int row0 = u.pm * 256 + wr * 64 + fr_, col0 = u.pn * 256 + wc * 32 + fq_ * 8;
#pragma unroll
        for (int am = 0; am < 4; ++am) { const int ai = am >> 1, m0 = (am & 1) * 2;
            u32x4 hh[4][2], ll[4][2];
#pragma unroll
            for (int m = m0; m < m0 + 2; ++m)
#pragma unroll
                for (int bj = 0; bj < 2; ++bj) { const size_t off = (size_t)(row0 + ai * 128 + m * 16) * D + col0 + bj * 128; hh[m][bj] = *(const u32x4*)(H + off); ll[m][bj] = *(const u32x4*)(L + off); }
#pragma unroll
            for (int m = m0; m < m0 + 2; ++m) {
                float ss = 0.f;
#pragma unroll
                for (int bj = 0; bj < 2; ++bj) {
                    const size_t off = (size_t)(row0 + ai * 128 + m * 16) * D + col0 + bj * 128;
                    const u32x4 h4 = hh[m][bj], l4 = ll[m][bj];
                    f32x4 a = {bflo(h4.x) + bflo(l4.x), bfhi(h4.x) + bfhi(l4.x), bflo(h4.y) + bflo(l4.y), bfhi(h4.y) + bfhi(l4.y)};
                    f32x4 b = {bflo(h4.z) + bflo(l4.z), bfhi(h4.z) + bfhi(l4.z), bflo(h4.w) + bflo(l4.w), bfhi(h4.w) + bfhi(l4.w)};
                    a += acc[ai][bj][m][0] * scale; b += acc[ai][bj][m][1] * scale;
                    if (last) { *(f32x4*)(x_ + off) = a; *(f32x4*)(x_ + off + 4) = b; }
                    else {
                        u32x4 hb; hb.x = cvtpk(a.x, a.y); hb.y = cvtpk(a.z, a.w); hb.z = cvtpk(b.x, b.y); hb.w = cvtpk(b.z, b.w);
                        u32x4 lb; lb.x = cvtpk(a.x - bflo(hb.x), a.y - bfhi(hb.x)); lb.y = cvtpk(a.z - bflo(hb.y), a.w - bfhi(hb.y)); lb.z = cvtpk(b.x - bflo(hb.z), b.y - bfhi(hb.z)); lb.w = cvtpk(b.z - bflo(hb.w), b.w - bfhi(hb.w));
                        *(u32x4*)(H + off) = hb; *(u32x4*)(L + off) = lb;
                    }
                    ss += (a.x * a.x + a.y * a.y) + (a.z * a.z + a.w * a.w) + (b.x * b.x + b.y * b.y) + (b.z * b.z + b.w * b.w);
                }
                ss += __shfl_xor(ss, 16); ss += __shfl_xor(ss, 32);
                if (fq_ == 0) xch[(ai * 128 + wr * 64 + m * 16 + fr_) * 4 + wc] = ss;
            }
        }
        asm volatile("s_waitcnt lgkmcnt(0)" ::: "memory"); __builtin_amdgcn_s_barrier(); asm volatile("" ::: "memory");
        int tl = threadIdx.x; OPQ_V(tl);
        if (tl < 256) { const f32x4 s4 = *(const LAS f32x4*)(xch + tl * 4); ((float*)(w_ + WS_SS))[(size_t)(u.pm * 256 + tl) * 8 + u.pn] = (s4.x + s4.y) + (s4.z + s4.w); }
    }
};
struct EpiT {
    static constexpr bool PERM = true, AFTER_DRAIN = false;
    unsigned char* ws;
    __device__ __forceinline__ void operator()(const pg8::f32x4 (&acc)[2][2][4][2], const pg8::Unit& u, int wr, int wc, int fr, int fq) const {
        EPI_HEAD
        bf16* T = (bf16*)(w_ + WS_T); const bf16* mg = (const bf16*)(w_ + WS_MG);
        const int row0 = u.pm * 256 + wr * 64 + fr_, col0 = u.pn * 256 + wc * 32 + fq_ * 8;
#pragma unroll
        for (int ai = 0; ai < 2; ++ai) {
            u32x4 gg[4][2];
#pragma unroll
            for (int m = 0; m < 4; ++m)
#pragma unroll
                for (int bj = 0; bj < 2; ++bj) gg[m][bj] = *(const u32x4*)(mg + (size_t)(row0 + ai * 128 + m * 16) * 4096 + 2048 + col0 + bj * 128);
#pragma unroll
            for (int m = 0; m < 4; ++m)
#pragma unroll
                for (int bj = 0; bj < 2; ++bj) {
                    const size_t row = row0 + ai * 128 + m * 16; const int col = col0 + bj * 128;
                    const u32x4 g = gg[m][bj];
                    float v[8];
                    v[0] = bflo(g.x) * acc[ai][bj][m][0][0]; v[1] = bfhi(g.x) * acc[ai][bj][m][0][1]; v[2] = bflo(g.y) * acc[ai][bj][m][0][2]; v[3] = bfhi(g.y) * acc[ai][bj][m][0][3];
                    v[4] = bflo(g.z) * acc[ai][bj][m][1][0]; v[5] = bfhi(g.z) * acc[ai][bj][m][1][1]; v[6] = bflo(g.w) * acc[ai][bj][m][1][2]; v[7] = bfhi(g.w) * acc[ai][bj][m][1][3];
                    *(u32x4*)(T + row * D + col) = pack8(v);
                }
        }
    }
};
struct EpiMerge {
    static constexpr bool PERM = true, AFTER_DRAIN = false;
    unsigned char* ws;
    __device__ __forceinline__ void operator()(const pg8::f32x4 (&acc)[2][2][4][2], const pg8::Unit& u, int wr, int wc, int fr, int fq) const {
        EPI_HEAD
        bf16* O = (bf16*)(w_ + WS_MRG); const bf16* T = (const bf16*)(w_ + WS_T); const bf16* mg = (const bf16*)(w_ + WS_MG);
        const int row0 = u.pm * 256 + wr * 64 + fr_, col0 = u.pn * 256 + wc * 32 + fq_ * 8;
#pragma unroll
        for (int am = 0; am < 4; ++am) { const int ai = am >> 1, m0 = (am & 1) * 2;
            u32x4 gg[4][2], tt[4][2];
#pragma unroll
            for (int m = m0; m < m0 + 2; ++m)
#pragma unroll
                for (int bj = 0; bj < 2; ++bj) { const size_t row = row0 + ai * 128 + m * 16; const int col = col0 + bj * 128; gg[m][bj] = *(const u32x4*)(mg + row * 4096 + col); tt[m][bj] = *(const u32x4*)(T + row * D + col); }
#pragma unroll
            for (int m = m0; m < m0 + 2; ++m)
#pragma unroll
                for (int bj = 0; bj < 2; ++bj) {
                    const size_t row = row0 + ai * 128 + m * 16; const int col = col0 + bj * 128;
                    const u32x4 g = gg[m][bj], t = tt[m][bj];
                    float v[8];
                    v[0] = bflo(g.x) * acc[ai][bj][m][0][0] + bflo(t.x); v[1] = bfhi(g.x) * acc[ai][bj][m][0][1] + bfhi(t.x);
                    v[2] = bflo(g.y) * acc[ai][bj][m][0][2] + bflo(t.y); v[3] = bfhi(g.y) * acc[ai][bj][m][0][3] + bfhi(t.y);
                    v[4] = bflo(g.z) * acc[ai][bj][m][1][0] + bflo(t.z); v[5] = bfhi(g.z) * acc[ai][bj][m][1][1] + bfhi(t.z);
                    v[6] = bflo(g.w) * acc[ai][bj][m][1][2] + bflo(t.w); v[7] = bfhi(g.w) * acc[ai][bj][m][1][3] + bfhi(t.w);
                    *(u32x4*)(O + row * D + col) = pack8(v);
                }
        }
    }
};
struct EpiTM {
    static constexpr bool PERM = true, AFTER_DRAIN = false;
    unsigned char* ws;
    __device__ __forceinline__ void operator()(const pg8::f32x4 (&acc)[2][2][4][2], const pg8::Unit& u, int wr, int wc, int fr, int fq) const {
        if (u.kind == 0) { EpiT t{ws}; t(acc, u, wr, wc, fr, fq); } else { EpiMerge m{ws}; m(acc, u, wr, wc, fr, fq); }
    }
};
struct EpiIn {
    static constexpr bool PERM = true, AFTER_DRAIN = false;
    unsigned char* ws; int l;
    template <int KIND>
    __device__ __forceinline__ void act_tile(const pg8::f32x4 (&acc)[2][2][4][2], const float (&rs)[2][4], unsigned char* w_, int row0, int colt, int statslot, int fq_) const {
        bf16* base = (bf16*)(w_ + (KIND == 0 ? WS_U : (KIND == 1 ? WS_V : WS_MG)));
        constexpr int ldc = KIND == 2 ? 4096 : 1024;
#pragma unroll
        for (int ai = 0; ai < 2; ++ai)
#pragma unroll
            for (int m = 0; m < 4; ++m) {
                const int row = row0 + ai * 128 + m * 16;
                float s1 = 0.f, s2 = 0.f;
#pragma unroll
                for (int bj = 0; bj < 2; ++bj) {
                    float v[8];
#pragma unroll
                    for (int n = 0; n < 2; ++n)
#pragma unroll
                        for (int j = 0; j < 4; ++j) {
                            const float a = acc[ai][bj][m][n][j] * rs[ai][m];
                            const float r = KIND == 2 ? sigm(a) : gelu_tanh(a);
                            v[n * 4 + j] = r;
                            if (KIND == 1) { s1 += r; s2 += r * r; }
                        }
                    __builtin_nontemporal_store(pack8(v), (u32x4*)(base + (size_t)row * ldc + colt + bj * 128));
                }
                if (KIND == 1) {
                    s1 += __shfl_xor(s1, 16); s1 += __shfl_xor(s1, 32); s2 += __shfl_xor(s2, 16); s2 += __shfl_xor(s2, 32);
                    if (fq_ == 0) { float* sp = (float*)(w_ + WS_VSTAT) + ((size_t)row * 16 + statslot) * 2; sp[0] = s1; sp[1] = s2; }
                }
            }
    }
    __device__ __forceinline__ void operator()(const pg8::f32x4 (&acc)[2][2][4][2], const pg8::Unit& u, int wr, int wc, int fr, int fq) const {
        EPI_HEAD
        const int row0 = u.pm * 256 + wr * 64 + fr_, pn = u.pn;
        EPI_RSTD(rs)
        if (pn < 10) {
            bf16* Q = (bf16*)(w_ + WS_Q); bf16* KV = (bf16*)(w_ + WS_KV);
            const float* par = (const float*)(w_ + (size_t)l * LW_BYTES + LW_PAR);
            const bool isq = pn < 4; const int ten = pn - 4;
            const bool hasn = isq || ten == 2 || ten == 4;
            const float* gn = par + (isq ? PAR_QN : (ten == 2 ? PAR_KN + 64 : PAR_KN + 128));
            const bool tr = (!isq) && (ten == 3 || ten == 5);
            float gv[2][8];
#pragma unroll
            for (int bj = 0; bj < 2; ++bj)
#pragma unroll
                for (int e = 0; e < 8; ++e) gv[bj][e] = hasn ? gn[bj * 32 + fq_ * 8 + e] : 1.f;
#pragma unroll
            for (int ai = 0; ai < 2; ++ai)
#pragma unroll
                for (int m = 0; m < 4; ++m) {
                    const int row = row0 + ai * 128 + m * 16;
                    float ss = 0.f;
#pragma unroll
                    for (int bj = 0; bj < 2; ++bj)
#pragma unroll
                        for (int n = 0; n < 2; ++n)
#pragma unroll
                            for (int j = 0; j < 4; ++j) ss += (acc[ai][bj][m][n][j] * rs[ai][m]) * (acc[ai][bj][m][n][j] * rs[ai][m]);
                    ss += __shfl_xor(ss, 16); ss += __shfl_xor(ss, 32);
                    const float rstd = hasn ? rsqrtf(ss * (1.f / 64.f) + EPS) : 1.f;
                    const int b = row >> 11, s = row & 2047;
#pragma unroll
                    for (int bj = 0; bj < 2; ++bj) {
                        float v[8];
#pragma unroll
                        for (int n = 0; n < 2; ++n)
#pragma unroll
                            for (int j = 0; j < 4; ++j) v[n * 4 + j] = acc[ai][bj][m][n][j] * rs[ai][m] * rstd * gv[bj][n * 4 + j];
                        if (isq) *(u32x4*)(Q + (size_t)row * 1024 + (pn * 4 + wc) * 64 + bj * 32 + fq_ * 8) = pack8(v);
                        else if (!tr) *(u32x4*)(KV + (size_t)ten * KV_ELEMS + ((size_t)(b * 4 + wc) * 2048 + s) * 64 + bj * 32 + fq_ * 8) = pack8(v);
                        else {
                            bf16* p = KV + (size_t)ten * KV_ELEMS + ((size_t)(b * 4 + wc) * 64 + bj * 32 + fq_ * 8) * 2048 + s;
#pragma unroll
                            for (int e = 0; e < 8; ++e) p[(size_t)e * 2048] = f2bf(v[e]);
                        }
                    }
                }
        } else if (pn < 34) {
            if (pn < 14) act_tile<0>(acc, rs, w_, row0, (pn - 10) * 256 + wc * 32 + fq_ * 8, 0, fq_);
            else if (pn < 18) act_tile<1>(acc, rs, w_, row0, (pn - 14) * 256 + wc * 32 + fq_ * 8, (pn - 14) * 4 + wc, fq_);
            else act_tile<2>(acc, rs, w_, row0, (pn - 18) * 256 + wc * 32 + fq_ * 8, 0, fq_);
        } else {
            float* GATES = (float*)(w_ + WS_GATES);
#pragma unroll
            for (int ai = 0; ai < 2; ++ai)
#pragma unroll
                for (int m = 0; m < 4; ++m) {
                    const int row = row0 + ai * 128 + m * 16;
#pragma unroll
                    for (int n = 0; n < 2; ++n)
#pragma unroll
                        for (int j = 0; j < 4; ++j) { const int col = wc * 32 + fq_ * 8 + n * 4 + j; if (col < 48) GATES[(size_t)row * 48 + col] = sigm(acc[ai][0][m][n][j] * rs[ai][m]); }
                }
        }
    }
};

__device__ __forceinline__ void p0_item(const float* s0, const float* s1, int nv0, int nv1, int N, bf16* dst, int K, LAS float* scr, int lane, const float* gain  ) {
    const int r = lane >> 4, c4 = lane & 15, hf = c4 >> 3, cc = (c4 & 7) * 4;
    const float* src = (hf ? s1 : s0) + (size_t)r * N + cc;
    const bool ok = cc < (hf ? nv1 : nv0);
    f32x4 v[16];
#pragma unroll
    for (int i = 0; i < 16; ++i) v[i] = ok ? *(const f32x4*)(src + (size_t)(4 * i) * N) : (f32x4){0.f, 0.f, 0.f, 0.f};
#pragma unroll
    for (int i = 0; i < 16; ++i) { const float gk = gain ? gain[4 * i + r] : 1.f; LAS float* d = scr + (4 * i + r) * 65 + 4 * c4; d[0] = v[i].x * gk; d[1] = v[i].y * gk; d[2] = v[i].z * gk; d[3] = v[i].w * gk; }
    const int c = lane & 7;
#pragma unroll
    for (int j = 0; j < 8; ++j) {
        const int n = (lane >> 3) + 8 * j; const LAS float* s = scr + (8 * c) * 65 + n;
        u32x4 o; o.x = cvtpk(s[0 * 65], s[1 * 65]); o.y = cvtpk(s[2 * 65], s[3 * 65]); o.z = cvtpk(s[4 * 65], s[5 * 65]); o.w = cvtpk(s[6 * 65], s[7 * 65]);
        *(u32x4*)(dst + (size_t)n * K + 8 * c) = o;
    }
}
__device__ __forceinline__ int win_src_col(int n0, int& nvalid) {
    const int tile = n0 >> 8, r = n0 & 255, bj = r >> 7, wc = (r & 127) >> 5;
    nvalid = 32;
    if (tile < 4) return (tile * 4 + wc) * 64 + bj * 32;
    if (tile < 10) return 1024 + (tile - 4) * 256 + wc * 64 + bj * 32;
    if (tile < 18) return 2608 + (tile - 10) * 256 + r;
    if (tile < 34) return 4656 + (tile - 18) * 256 + r;
    nvalid = r < 48 ? (48 - r < 32 ? 48 - r : 32) : 0;
    return r < 48 ? 2560 + r : 0;
}
__device__ __forceinline__ void p0_matrix(int type  , const float* W0, const float* W1, int K, int Nsrc, int Ndst, bf16* dst, LAS float* scr, int gw, int NGW, int lane, const float* gain) {
    const int nruns = Ndst >> 6, nitems = (K >> 6) * nruns;
    for (int it = gw; it < nitems; it += NGW) {
        const int kb = it / nruns, nb = it - kb * nruns, n0 = nb * 64, k0 = kb * 64;
        const float* src = W0; int c0 = n0, c1 = n0 + 32, nv0 = 32, nv1 = 32;
        if (type == 1) { const int tile = n0 >> 8, r = n0 & 255; src = r < 128 ? W0 : W1; c0 = tile * 128 + (r & 127); c1 = c0 + 32; }
        else if (type == 2) { c0 = win_src_col(n0, nv0); c1 = win_src_col(n0 + 32, nv1); }
        const float* rowp = src + (size_t)k0 * Nsrc;
        p0_item(rowp + c0, rowp + c1, nv0, nv1, Nsrc, dst + (size_t)n0 * K + k0, K, scr, lane, gain ? gain + k0 : nullptr);
    }
}
constexpr unsigned CV_GU1 = 1u, CV_D1 = 2u, CV_WIN = 4u, CV_PN = 8u, CV_PS = 16u, CV_O = 32u, CV_GU2 = 64u, CV_D2 = 128u, CV_C1K = 256u, CV_C1V = 512u, CV_C2K = 1024u, CV_C2V = 2048u;
constexpr unsigned CV_SMALL = CV_PN | CV_PS | CV_O | CV_C1K | CV_C1V | CV_C2K | CV_C2V;
struct CvPtrs { const float* in[27]; };
#define CV_ARGS(a_) CvPtrs{{nullptr, nullptr, a_.in[2], a_.in[3], a_.in[4], a_.in[5], a_.in[6], a_.in[7], nullptr, nullptr, nullptr, nullptr, a_.in[12], a_.in[13], a_.in[14], a_.in[15], nullptr, nullptr, nullptr, nullptr, a_.in[20], a_.in[21], a_.in[22], a_.in[23], a_.in[24], a_.in[25], a_.in[26]}}
__device__ __forceinline__ void conv_set(const CvPtrs args, unsigned char* ws, int l, unsigned mask, LAS float* scr, int gw, int NGW, int lane) {
    unsigned char* lw = ws + (size_t)l * LW_BYTES;
    if (mask & CV_GU1) p0_matrix(1, args.in[3] + (size_t)l * D * FF, args.in[4] + (size_t)l * D * FF, D, FF, 2 * FF, (bf16*)(lw + LW_GU1), scr, gw, NGW, lane, args.in[2] + (size_t)l * D);
    if (mask & CV_D1) p0_matrix(0, args.in[5] + (size_t)l * FF * D, nullptr, FF, D, D, (bf16*)(lw + LW_D1), scr, gw, NGW, lane, nullptr);
    if (mask & CV_WIN) p0_matrix(2, args.in[7] + (size_t)l * D * INW, nullptr, D, INW, INP, (bf16*)(lw + LW_IN), scr, gw, NGW, lane, args.in[6] + (size_t)l * D);
    if (mask & CV_PN) p0_matrix(0, args.in[20] + (size_t)l * 1024 * D, nullptr, 1024, D, D, (bf16*)(lw + LW_PN), scr, gw, NGW, lane, nullptr);
    if (mask & CV_PS) p0_matrix(0, args.in[21] + (size_t)l * 1024 * D, nullptr, 1024, D, D, (bf16*)(lw + LW_PS), scr, gw, NGW, lane, nullptr);
    if (mask & CV_O) p0_matrix(0, args.in[22] + (size_t)l * D * D, nullptr, D, D, D, (bf16*)(lw + LW_O), scr, gw, NGW, lane, nullptr);
    if (mask & CV_GU2) p0_matrix(1, args.in[24] + (size_t)l * D * FF, args.in[25] + (size_t)l * D * FF, D, FF, 2 * FF, (bf16*)(lw + LW_GU2), scr, gw, NGW, lane, args.in[23] + (size_t)l * D);
    if (mask & CV_D2) p0_matrix(0, args.in[26] + (size_t)l * FF * D, nullptr, FF, D, D, (bf16*)(lw + LW_D2), scr, gw, NGW, lane, nullptr);
    if (mask & CV_C1K) p0_matrix(0, args.in[12] + (size_t)l * 2048 * 256, nullptr, 2048, 256, 256, (bf16*)(lw + LW_C1K), scr, gw, NGW, lane, nullptr);
    if (mask & CV_C1V) p0_matrix(0, args.in[14] + (size_t)l * 2048 * 256, nullptr, 2048, 256, 256, (bf16*)(lw + LW_C1V), scr, gw, NGW, lane, nullptr);
    if (mask & CV_C2K) p0_matrix(0, args.in[13] + (size_t)l * 256 * 64, nullptr, 256, 64, 64, (bf16*)(lw + LW_C2K), scr, gw, NGW, lane, nullptr);
    if (mask & CV_C2V) p0_matrix(0, args.in[15] + (size_t)l * 256 * 64, nullptr, 256, 64, 64, (bf16*)(lw + LW_C2V), scr, gw, NGW, lane, nullptr);
}
__device__ __forceinline__ void prep_row(const float* xrow, bf16* hrow, bf16* lrow, float* ssrow, int lane) {
    float ss = 0.f;
#pragma unroll
    for (int j = 0; j < 8; ++j) {
        const f32x4 v = *(const f32x4*)(xrow + 4 * lane + 256 * j);
        ss += (v.x * v.x + v.y * v.y) + (v.z * v.z + v.w * v.w);
        u32x2 o; o.x = cvtpk(v.x, v.y); o.y = cvtpk(v.z, v.w);
        u32x2 lo; lo.x = cvtpk(v.x - bflo(o.x), v.y - bfhi(o.x)); lo.y = cvtpk(v.z - bflo(o.y), v.w - bfhi(o.y));
        *(u32x2*)(hrow + 4 * lane + 256 * j) = o; *(u32x2*)(lrow + 4 * lane + 256 * j) = lo;
    }
    ss = wave_sum(ss);
    if (lane < 8) ssrow[lane] = lane == 0 ? ss : 0.f;
}

__device__ __forceinline__ void compress_unit(int cu, const bf16* KVB, const bf16* w1k, const bf16* w1v, const bf16* w2k, const bf16* w2v, const float* bias1, const float* kn0,
                                              bf16* KCN, bf16* VCT, unsigned char* lds) {
    int tid_ = threadIdx.x; OPQ_V(tid_); const int tid = tid_, lane = tid & 63, w = __builtin_amdgcn_readfirstlane(tid >> 6), qi = lane & 15, q4 = lane >> 4;
    const int isv = cu >> 7, bg = (cu >> 3) & 15, r = cu & 7;
    const bf16* src = KVB + (size_t)isv * KV_ELEMS + (size_t)bg * 2048 * 64;
    const bf16* w1 = isv ? w1v : w1k; const bf16* w2 = isv ? w2v : w2k;
    const bf16* arow = src + (size_t)(16 * (16 * r + qi)) * 64 + q4 * 8;
    const bf16* b0p = w1 + (size_t)(32 * w + qi) * 2048 + q4 * 8;
    const bf16* b1p = b0p + (size_t)16 * 2048;
    f32x4 h0 = {0.f, 0.f, 0.f, 0.f}, h1 = {0.f, 0.f, 0.f, 0.f};
    bf16x8 fa[2][8], fb0[2][8], fb1[2][8];
#define CU_LOAD(set_, bt_) do { _Pragma("unroll") for (int i_ = 0; i_ < 8; ++i_) { const int ko_ = ((bt_) * 8 + i_) * 32; fa[set_][i_] = *(const bf16x8*)(arow + ko_); fb0[set_][i_] = *(const bf16x8*)(b0p + ko_); fb1[set_][i_] = *(const bf16x8*)(b1p + ko_); } } while (0)
#define CU_MMA(set_) do { _Pragma("unroll") for (int i_ = 0; i_ < 8; ++i_) { h0 = __builtin_amdgcn_mfma_f32_16x16x32_bf16(fa[set_][i_], fb0[set_][i_], h0, 0, 0, 0); h1 = __builtin_amdgcn_mfma_f32_16x16x32_bf16(fa[set_][i_], fb1[set_][i_], h1, 0, 0, 0); } } while (0)
    CU_LOAD(0, 0);
#pragma unroll 1
    for (int bt = 0; bt < 8; bt += 2) {
        CU_LOAD(1, bt + 1);
        CU_MMA(0);
        if (bt + 2 < 8) CU_LOAD(0, bt + 2);
        CU_MMA(1);
    }
#undef CU_LOAD
#undef CU_MMA
    bf16* hid = (bf16*)lds;
    const float bb0 = bias1[isv * 256 + 32 * w + qi], bb1 = bias1[isv * 256 + 32 * w + 16 + qi];
#pragma unroll
    for (int j = 0; j < 4; ++j) { hid[(4 * q4 + j) * 264 + 32 * w + qi] = f2bf(siluf_(h0[j] + bb0)); hid[(4 * q4 + j) * 264 + 32 * w + 16 + qi] = f2bf(siluf_(h1[j] + bb1)); }
    __syncthreads();
    if (w == 0) {
        f32x4 o[4];
#pragma unroll
        for (int et = 0; et < 4; ++et) o[et] = (f32x4){0.f, 0.f, 0.f, 0.f};
        bf16x8 wb[8][4];
#pragma unroll
        for (int k2 = 0; k2 < 8; ++k2)
#pragma unroll
            for (int et = 0; et < 4; ++et) wb[k2][et] = *(const bf16x8*)(w2 + (size_t)(et * 16 + qi) * 256 + k2 * 32 + q4 * 8);
        asm volatile("" ::: "memory");
#pragma unroll
        for (int k2 = 0; k2 < 8; ++k2) {
            const bf16x8 a = *(const bf16x8*)(hid + qi * 264 + k2 * 32 + q4 * 8);
#pragma unroll
            for (int et = 0; et < 4; ++et) o[et] = __builtin_amdgcn_mfma_f32_16x16x32_bf16(a, wb[k2][et], o[et], 0, 0, 0);
        }
        if (!isv) {
#pragma unroll
            for (int j = 0; j < 4; ++j) {
                float ss = o[0][j] * o[0][j] + o[1][j] * o[1][j] + o[2][j] * o[2][j] + o[3][j] * o[3][j];
                ss += __shfl_xor(ss, 1); ss += __shfl_xor(ss, 2); ss += __shfl_xor(ss, 4); ss += __shfl_xor(ss, 8);
                const float rstd = rsqrtf(ss * (1.f / 64.f) + EPS);
                const int c = 16 * r + 4 * q4 + j;
#pragma unroll
                for (int et = 0; et < 4; ++et) KCN[((size_t)bg * 128 + c) * 64 + et * 16 + qi] = (c < 127) ? f2bf(o[et][j] * rstd * kn0[et * 16 + qi]) : (bf16)0;
            }
        } else {
            const int c0 = 16 * r + 4 * q4;
#pragma unroll
            for (int et = 0; et < 4; ++et) {
                u32x2 pk; pk.x = cvtpk(o[et][0], o[et][1]); pk.y = cvtpk(o[et][2], (c0 + 3 < 127) ? o[et][3] : 0.f);
                *(u32x2*)(VCT + ((size_t)bg * 64 + et * 16 + qi) * 128 + c0) = pk;
            }
        }
    }
    __syncthreads();
}

__device__ __forceinline__ void sgu_unit(int su, const bf16* U, const bf16* V, const float* VSTAT, const float* lng, const float* lnb, const bf16* WS  , const float* bs  ,
                                         bf16* SG, unsigned char* lds) {
    int tid_ = threadIdx.x; OPQ_V(tid_); const int tid = tid_, lane = tid & 63, w = __builtin_amdgcn_readfirstlane(tid >> 6), qi = lane & 15, q4 = lane >> 4;
    const int cc = su >> 3, g = su & 7, r0 = cc * 128;
    float* mu = (float*)lds; float* rs = mu + 128; bf16* vnT = (bf16*)(lds + 1024);
    const int tt = w, nks = (16 * tt + 15) / 32 + 1, t = tt * 16 + qi;
    u32x4 vraw[4];
#pragma unroll
    for (int i = 0; i < 4; ++i) { const int id = tid + 512 * i, s = id >> 4, dc = id & 15; vraw[i] = *(const u32x4*)(V + (size_t)(r0 + s) * 1024 + g * 128 + dc * 8); }
    bf16x8 bw[4];
    const bf16* wp = WS + ((size_t)g * 128 + tt * 16 + qi) * 128 + q4 * 8;
#pragma unroll
    for (int ks = 0; ks < 4; ++ks) bw[ks] = (ks < nks) ? *(const bf16x8*)(wp + ks * 32) : (bf16x8){0, 0, 0, 0, 0, 0, 0, 0};
    u32x2 uu[8];
#pragma unroll
    for (int dt = 0; dt < 8; ++dt) uu[dt] = *(const u32x2*)(U + (size_t)(r0 + t) * 1024 + g * 128 + dt * 16 + q4 * 4);
    const float bias = bs[g * 128 + t];
    if (tid < 128) {
        const float* sp = VSTAT + (size_t)(r0 + tid) * 32; float s1 = 0.f, s2 = 0.f;
#pragma unroll
        for (int i = 0; i < 8; ++i) { const f32x4 q = *(const f32x4*)(sp + 4 * i); s1 += q.x + q.z; s2 += q.y + q.w; }
        const float mean = s1 * (1.f / 1024.f); float var = s2 * (1.f / 1024.f) - mean * mean; var = var > 0.f ? var : 0.f;
        mu[tid] = mean; rs[tid] = rsqrtf(var + EPS);
    }
    __syncthreads();
#pragma unroll
    for (int i = 0; i < 4; ++i) {
        const int id = tid + 512 * i, s = id >> 4, dc = id & 15;
        const u32x4 raw = vraw[i];
        const float m_ = mu[s], r_ = rs[s];
        const f32x4 g0 = *(const f32x4*)(lng + g * 128 + dc * 8), g1 = *(const f32x4*)(lng + g * 128 + dc * 8 + 4), b0 = *(const f32x4*)(lnb + g * 128 + dc * 8), b1 = *(const f32x4*)(lnb + g * 128 + dc * 8 + 4);
        const float gp[8] = {g0.x, g0.y, g0.z, g0.w, g1.x, g1.y, g1.z, g1.w}, bp[8] = {b0.x, b0.y, b0.z, b0.w, b1.x, b1.y, b1.z, b1.w};
        float v[8] = {bflo(raw.x), bfhi(raw.x), bflo(raw.y), bfhi(raw.y), bflo(raw.z), bfhi(raw.z), bflo(raw.w), bfhi(raw.w)};
#pragma unroll
        for (int e = 0; e < 8; ++e) vnT[(dc * 8 + e) * 136 + s] = f2bf((v[e] - m_) * r_ * gp[e] + bp[e]);
    }
    __syncthreads();
    f32x4 acc[8];
#pragma unroll
    for (int dt = 0; dt < 8; ++dt) acc[dt] = (f32x4){0.f, 0.f, 0.f, 0.f};
#pragma unroll
    for (int ks = 0; ks < 4; ++ks) if (ks < nks) {
#pragma unroll
        for (int dt = 0; dt < 8; ++dt) { const bf16x8 av = *(const bf16x8*)(vnT + (dt * 16 + qi) * 136 + ks * 32 + q4 * 8); acc[dt] = __builtin_amdgcn_mfma_f32_16x16x32_bf16(av, bw[ks], acc[dt], 0, 0, 0); }
    }
#pragma unroll
    for (int dt = 0; dt < 8; ++dt) {
        const size_t off = (size_t)(r0 + t) * 1024 + g * 128 + dt * 16 + q4 * 4;
        u32x2 o; o.x = cvtpk(bflo(uu[dt].x) * (acc[dt][0] + bias), bfhi(uu[dt].x) * (acc[dt][1] + bias)); o.y = cvtpk(bflo(uu[dt].y) * (acc[dt][2] + bias), bfhi(uu[dt].y) * (acc[dt][3] + bias));
        *(u32x2*)(SG + off) = o;
    }
    __syncthreads();
}

__device__ __forceinline__ void half_bar(LAS unsigned* ctr, unsigned& target) {
    target += 4u;
    asm volatile("s_waitcnt lgkmcnt(0)" ::: "memory");
    if ((threadIdx.x & 63) == 0) (void)__hip_atomic_fetch_add(ctr, 1u, __ATOMIC_RELAXED, __HIP_MEMORY_SCOPE_WORKGROUP);
    while (__hip_atomic_load(ctr, __ATOMIC_RELAXED, __HIP_MEMORY_SCOPE_WORKGROUP) < target) __builtin_amdgcn_s_sleep(1);
    asm volatile("" ::: "memory");
}
constexpr int CSP_HID = 0, CSP_CTR = 8448, CSP_SGU = 9216;
__device__ __forceinline__ void cs_pair(int cu, int su0, int su1, const bf16* KVB, const bf16* w1k, const bf16* w1v, const bf16* w2k, const bf16* w2v, const float* bias1, const float* kn0, bf16* KCN, bf16* VCT,
                                        const bf16* U, const bf16* V, const float* VSTAT, const float* lng, const float* lnb, const bf16* WS, const float* bs, bf16* SG, unsigned char* lds) {
    int tid_ = threadIdx.x; OPQ_V(tid_); const int tid = tid_, lane = tid & 63, w = __builtin_amdgcn_readfirstlane(tid >> 6), qi = lane & 15, q4 = lane >> 4;
    LAS unsigned* ctr = (LAS unsigned*)(lds_base() + CSP_CTR);
    if (tid < 2) ctr[tid] = 0u;
    __syncthreads();
    unsigned target = 0u;
    if (w < 4) {
        const int isv = cu >> 7, bg = (cu >> 3) & 15, r = cu & 7;
        const bf16* src = KVB + (size_t)isv * KV_ELEMS + (size_t)bg * 2048 * 64;
        const bf16* w1 = isv ? w1v : w1k; const bf16* w2 = isv ? w2v : w2k;
        const bf16* arow = src + (size_t)(16 * (16 * r + qi)) * 64 + q4 * 8;
        const bf16* bp = w1 + (size_t)(64 * w + qi) * 2048 + q4 * 8;
        f32x4 h[4];
#pragma unroll
        for (int nt = 0; nt < 4; ++nt) h[nt] = (f32x4){0.f, 0.f, 0.f, 0.f};
        bf16x8 fa[2][4], fb[2][4][4];
#define CP_LOAD(set_, bt_) do { _Pragma("unroll") for (int i_ = 0; i_ < 4; ++i_) { const int ko_ = ((bt_) * 4 + i_) * 32; fa[set_][i_] = *(const bf16x8*)(arow + ko_); \
            _Pragma("unroll") for (int nt = 0; nt < 4; ++nt) fb[set_][i_][nt] = *(const bf16x8*)(bp + (size_t)nt * 16 * 2048 + ko_); } } while (0)
#define CP_MMA(set_) do { _Pragma("unroll") for (int i_ = 0; i_ < 4; ++i_) _Pragma("unroll") for (int nt = 0; nt < 4; ++nt) h[nt] = __builtin_amdgcn_mfma_f32_16x16x32_bf16(fa[set_][i_], fb[set_][i_][nt], h[nt], 0, 0, 0); } while (0)
        CP_LOAD(0, 0);
#pragma unroll 1
        for (int bt = 0; bt < 16; bt += 2) {
            CP_LOAD(1, bt + 1);
            CP_MMA(0);
            if (bt + 2 < 16) CP_LOAD(0, bt + 2);
            CP_MMA(1);
        }
#undef CP_LOAD
#undef CP_MMA
        bf16* hid = (bf16*)(lds + CSP_HID);
#pragma unroll
        for (int nt = 0; nt < 4; ++nt) {
            const int col = 64 * w + 16 * nt + qi; const float bb = bias1[isv * 256 + col];
#pragma unroll
            for (int j = 0; j < 4; ++j) hid[(4 * q4 + j) * 264 + col] = f2bf(siluf_(h[nt][j] + bb));
        }
        half_bar(ctr, target);
        if (w == 0) {
            f32x4 o[4];
#pragma unroll
            for (int et = 0; et < 4; ++et) o[et] = (f32x4){0.f, 0.f, 0.f, 0.f};
            bf16x8 wb[8][4];
#pragma unroll
            for (int k2 = 0; k2 < 8; ++k2)
#pragma unroll
                for (int et = 0; et < 4; ++et) wb[k2][et] = *(const bf16x8*)(w2 + (size_t)(et * 16 + qi) * 256 + k2 * 32 + q4 * 8);
#pragma unroll
            for (int k2 = 0; k2 < 8; ++k2) {
                const bf16x8 a = *(const bf16x8*)(hid + qi * 264 + k2 * 32 + q4 * 8);
#pragma unroll
                for (int et = 0; et < 4; ++et) o[et] = __builtin_amdgcn_mfma_f32_16x16x32_bf16(a, wb[k2][et], o[et], 0, 0, 0);
            }
            if (!isv) {
#pragma unroll
                for (int j = 0; j < 4; ++j) {
                    float ss = o[0][j] * o[0][j] + o[1][j] * o[1][j] + o[2][j] * o[2][j] + o[3][j] * o[3][j];
                    ss += __shfl_xor(ss, 1); ss += __shfl_xor(ss, 2); ss += __shfl_xor(ss, 4); ss += __shfl_xor(ss, 8);
                    const float rstd = rsqrtf(ss * (1.f / 64.f) + EPS);
                    const int c = 16 * r + 4 * q4 + j;
#pragma unroll
                    for (int et = 0; et < 4; ++et) KCN[((size_t)bg * 128 + c) * 64 + et * 16 + qi] = (c < 127) ? f2bf(o[et][j] * rstd * kn0[et * 16 + qi]) : (bf16)0;
                }
            } else {
                const int c0 = 16 * r + 4 * q4;
#pragma unroll
                for (int et = 0; et < 4; ++et) {
                    u32x2 pk; pk.x = cvtpk(o[et][0], o[et][1]); pk.y = cvtpk(o[et][2], (c0 + 3 < 127) ? o[et][3] : 0.f);
                    *(u32x2*)(VCT + ((size_t)bg * 64 + et * 16 + qi) * 128 + c0) = pk;
                }
            }
        }
    } else {
        LAS unsigned* ctr2 = ctr + 1;
        const int wl = w - 4, t4 = tid - 256;
        float* mu = (float*)(lds + CSP_SGU); float* rs = mu + 128; bf16* vnT = (bf16*)(lds + CSP_SGU + 1024);
#pragma unroll 1
        for (int uu = 0; uu < 2; ++uu) {
            const int su = uu ? su1 : su0, cc = su >> 3, g = su & 7, r0 = cc * 128;
            u32x4 vraw[8];
#pragma unroll
            for (int i = 0; i < 8; ++i) { const int id = t4 + 256 * i, s = id >> 4, dc = id & 15; vraw[i] = *(const u32x4*)(V + (size_t)(r0 + s) * 1024 + g * 128 + dc * 8); }
            if (t4 < 128) {
                const float* sp = VSTAT + (size_t)(r0 + t4) * 32; float s1 = 0.f, s2 = 0.f;
#pragma unroll
                for (int i = 0; i < 8; ++i) { const f32x4 q = *(const f32x4*)(sp + 4 * i); s1 += q.x + q.z; s2 += q.y + q.w; }
                const float mean = s1 * (1.f / 1024.f); float var = s2 * (1.f / 1024.f) - mean * mean; var = var > 0.f ? var : 0.f;
                mu[t4] = mean; rs[t4] = rsqrtf(var + EPS);
            }
            half_bar(ctr2, target);
#pragma unroll
            for (int i = 0; i < 8; ++i) {
                const int id = t4 + 256 * i, s = id >> 4, dc = id & 15;
                const u32x4 raw = vraw[i];
                const float m_ = mu[s], r_ = rs[s];
                const f32x4 g0 = *(const f32x4*)(lng + g * 128 + dc * 8), g1 = *(const f32x4*)(lng + g * 128 + dc * 8 + 4), b0 = *(const f32x4*)(lnb + g * 128 + dc * 8), b1 = *(const f32x4*)(lnb + g * 128 + dc * 8 + 4);
                const float gp[8] = {g0.x, g0.y, g0.z, g0.w, g1.x, g1.y, g1.z, g1.w}, bp[8] = {b0.x, b0.y, b0.z, b0.w, b1.x, b1.y, b1.z, b1.w};
                float v[8] = {bflo(raw.x), bfhi(raw.x), bflo(raw.y), bfhi(raw.y), bflo(raw.z), bfhi(raw.z), bflo(raw.w), bfhi(raw.w)};
#pragma unroll
                for (int e = 0; e < 8; ++e) vnT[(dc * 8 + e) * 136 + ((((s >> 3) ^ dc) << 3) | (s & 7))] = f2bf((v[e] - m_) * r_ * gp[e] + bp[e]);
            }
            half_bar(ctr2, target);
#pragma unroll
            for (int th = 0; th < 2; ++th) {
                const int tt = 2 * wl + th, nks = (16 * tt + 15) / 32 + 1, t = tt * 16 + qi;
                const bf16* wp = WS + ((size_t)g * 128 + t) * 128 + q4 * 8;
                bf16x8 bw[4];
#pragma unroll
                for (int ks = 0; ks < 4; ++ks) bw[ks] = (ks < nks) ? *(const bf16x8*)(wp + ks * 32) : (bf16x8){0, 0, 0, 0, 0, 0, 0, 0};
                u32x2 uv[8];
#pragma unroll
                for (int dt = 0; dt < 8; ++dt) uv[dt] = *(const u32x2*)(U + (size_t)(r0 + t) * 1024 + g * 128 + dt * 16 + q4 * 4);
                const float bias = bs[g * 128 + t];
                f32x4 acc[8];
#pragma unroll
                for (int dt = 0; dt < 8; ++dt) acc[dt] = (f32x4){0.f, 0.f, 0.f, 0.f};
#pragma unroll
                for (int ks = 0; ks < 4; ++ks) if (ks < nks) {
#pragma unroll
                    for (int dt = 0; dt < 8; ++dt) { const bf16x8 av = *(const bf16x8*)(vnT + (dt * 16 + qi) * 136 + (((ks * 4 + q4) ^ (dt * 2 + (qi >> 3))) << 3)); acc[dt] = __builtin_amdgcn_mfma_f32_16x16x32_bf16(av, bw[ks], acc[dt], 0, 0, 0); }
                }
#pragma unroll
                for (int dt = 0; dt < 8; ++dt) {
                    const size_t off = (size_t)(r0 + t) * 1024 + g * 128 + dt * 16 + q4 * 4;
                    u32x2 o; o.x = cvtpk(bflo(uv[dt].x) * (acc[dt][0] + bias), bfhi(uv[dt].x) * (acc[dt][1] + bias)); o.y = cvtpk(bflo(uv[dt].y) * (acc[dt][2] + bias), bfhi(uv[dt].y) * (acc[dt][3] + bias));
                    *(u32x2*)(SG + off) = o;
                }
            }
            half_bar(ctr2, target);
        }
    }
    __syncthreads();
}

__device__ __forceinline__ bf16x8 pack_p(const float* a, const float* b) { u32x4 w; w.x = cvtpk(a[0], a[1]); w.y = cvtpk(a[2], a[3]); w.z = cvtpk(b[0], b[1]); w.w = cvtpk(b[2], b[3]); return __builtin_bit_cast(bf16x8, w); }
__device__ __forceinline__ bf16x8 ldv(const bf16* p) { const s16x4 lo = *(const s16x4*)p, hi = *(const s16x4*)(p + 16); return __builtin_shufflevector(lo, hi, 0, 1, 2, 3, 4, 5, 6, 7); }

constexpr float LOG2E = 1.4426950408889634f, SC2 = 0.125f * LOG2E;
constexpr int AL_KV0 = 40960, KV_STAGE = 18432, AKP = 144;
#define LBAR() do { asm volatile("s_waitcnt lgkmcnt(0)" ::: "memory"); __builtin_amdgcn_s_barrier(); asm volatile("" ::: "memory"); } while (0)
constexpr float MASKV = -3.0e38f;
typedef float f32x2 __attribute__((ext_vector_type(2)));
template <int MODE>
__device__ __forceinline__ void attn_step(const unsigned char* sb, int st, const bf16x8 qf0, const bf16x8 qf1, int t, int p0, bool sel, const float* bias, float cfar, f32x4 (&o)[4], float& mrun, float& lrun,
                                          int koff, int voff, int q4) {
    const int key0 = st * 64;
    f32x4 s[4];
#pragma unroll
    for (int kt = 0; kt < 4; ++kt) {
        const bf16x8 k0 = *(const bf16x8*)(sb + koff + kt * 16 * AKP), k1 = *(const bf16x8*)(sb + koff + kt * 16 * AKP + 64);
        s[kt] = (f32x4){0.f, 0.f, 0.f, 0.f};
        s[kt] = __builtin_amdgcn_mfma_f32_16x16x32_bf16(k0, qf0, s[kt], 0, 0, 0); s[kt] = __builtin_amdgcn_mfma_f32_16x16x32_bf16(k1, qf1, s[kt], 0, 0, 0);
    }
    const bool far = (p0 - (key0 + 63) >= BIAS_N - 1) && (MODE == 0 || (p0 + 15 - key0 < 512));
    bf16x8 vfr[4][2];
#pragma unroll
    for (int dt = 0; dt < 4; ++dt) { vfr[dt][0] = *(const bf16x8*)(sb + voff + dt * 16 * AKP); vfr[dt][1] = *(const bf16x8*)(sb + voff + dt * 16 * AKP + 64); }
    float fsc = 1.f, fc = 0.f;
    if (far) {
        fc = (MODE == 0 && !sel) ? MASKV : cfar; fsc = (MODE == 0 && !sel) ? 0.f : SC2;
    } else {
#pragma unroll
        for (int kt = 0; kt < 4; ++kt)
#pragma unroll
            for (int j = 0; j < 4; ++j) {
                const int dist = t - (key0 + kt * 16 + q4 * 4 + j);
                const bool v = (dist >= 0) && (MODE == 0 ? sel : (dist < 512));
                const int bi = dist < 0 ? 0 : (dist > BIAS_N - 1 ? BIAS_N - 1 : dist);
                const float l = s[kt][j] * SC2 + bias[bi];
                s[kt][j] = v ? l : MASKV;
            }
    }
    float mx = fmaxf(fmaxf(fmaxf(s[0][0], s[0][1]), fmaxf(s[0][2], s[0][3])), fmaxf(fmaxf(s[1][0], s[1][1]), fmaxf(s[1][2], s[1][3])));
    mx = fmaxf(mx, fmaxf(fmaxf(fmaxf(s[2][0], s[2][1]), fmaxf(s[2][2], s[2][3])), fmaxf(fmaxf(s[3][0], s[3][1]), fmaxf(s[3][2], s[3][3]))));
    mx = mx * fsc + fc;
    mx = fmaxf(mx, __shfl_xor(mx, 16)); mx = fmaxf(mx, __shfl_xor(mx, 32));
    const float mnew = fmaxf(mrun, mx);
    f32x4 ps4 = {0.f, 0.f, 0.f, 0.f};
    const float foff = fc - mnew;
#pragma unroll
    for (int kt = 0; kt < 4; ++kt) {
        s[kt] = s[kt] * fsc + foff;
#pragma unroll
        for (int j = 0; j < 4; ++j) s[kt][j] = __builtin_amdgcn_exp2f(s[kt][j]);
        ps4 += s[kt];
    }
    const float ps = (ps4.x + ps4.y) + (ps4.z + ps4.w);
    if (__ballot(mnew != mrun) != 0ull) {
        const float alpha = __builtin_amdgcn_exp2f(mrun - mnew);
        lrun *= alpha;
#pragma unroll
        for (int dt = 0; dt < 4; ++dt) o[dt] *= alpha;
    }
    lrun += ps; mrun = mnew;
    float pa[4][4];
#pragma unroll
    for (int kt = 0; kt < 4; ++kt)
#pragma unroll
        for (int j = 0; j < 4; ++j) pa[kt][j] = s[kt][j];
    const bf16x8 pf0 = pack_p(pa[0], pa[1]), pf1 = pack_p(pa[2], pa[3]);
#pragma unroll
    for (int dt = 0; dt < 4; ++dt) {
        o[dt] = __builtin_amdgcn_mfma_f32_16x16x32_bf16(vfr[dt][0], pf0, o[dt], 0, 0, 0); o[dt] = __builtin_amdgcn_mfma_f32_16x16x32_bf16(vfr[dt][1], pf1, o[dt], 0, 0, 0);
    }
}
template <int MODE>
__device__ __forceinline__ void attn_stream(const bf16* K, const bf16* VT, const bf16x8 qf0, const bf16x8 qf1, int t, int p0, int pb, unsigned selm, const float* bias, float cfar, f32x4 (&o)[4],
                                            int qi, int q4, int tid, unsigned char* lds) {
    const int st_hi = pb >> 1;
    const int st_lo = MODE == 1 ? ((pb * 32 - 511 > 0 ? pb * 32 - 511 : 0) >> 6) : 0;
    const int my_lo = MODE == 1 ? ((p0 - 511 > 0 ? p0 - 511 : 0) >> 6) : 0;
    float mrun = NEGF, lrun = 0.f;
#pragma unroll
    for (int dt = 0; dt < 4; ++dt) o[dt] = (f32x4){0.f, 0.f, 0.f, 0.f};
    const int crow = tid >> 3, cch = tid & 7;
    const bf16* kg = K + (size_t)crow * 64 + cch * 8;
    const bf16* vg = VT + (size_t)crow * 2048 + cch * 8;
    const int kdst = crow * AKP + cch * 16;
    const int vdst = 9216 + crow * AKP + ((cch >> 2) * 32 + (cch & 1) * 16 + ((cch & 3) >> 1) * 4) * 2;
    const int koff = qi * AKP + q4 * 16, voff = 9216 + qi * AKP + q4 * 16;
    unsigned char* sb0 = lds + AL_KV0; unsigned char* sb1 = sb0 + KV_STAGE;
#define AT_LOAD(s_, k_, v_) do { k_ = *(const u32x4*)(kg + (size_t)(s_) * 4096); v_ = *(const u32x4*)(vg + (s_) * 64); } while (0)
#define AT_STORE(sb_, k_, v_) do { *(u32x4*)((sb_) + kdst) = k_; *(u32x2*)((sb_) + vdst) = (u32x2){v_.x, v_.y}; *(u32x2*)((sb_) + vdst + 16) = (u32x2){v_.z, v_.w}; } while (0)
#define AT_COMPUTE(sb_, s_) do { bool sel_ = true; if (MODE == 0) sel_ = (selm >> (s_)) & 1u; \
        if ((s_) >= my_lo && (MODE == 1 || __ballot(sel_) != 0ull)) attn_step<MODE>(sb_, s_, qf0, qf1, t, p0, sel_, bias, cfar, o, mrun, lrun, koff, voff, q4); } while (0)
    u32x4 ka, va, kb = {0u, 0u, 0u, 0u}, vb = {0u, 0u, 0u, 0u};
    AT_LOAD(st_lo, ka, va);
    if (st_lo + 1 <= st_hi) AT_LOAD(st_lo + 1, kb, vb);
    AT_STORE(sb0, ka, va);
    LBAR();
    for (int st = st_lo; st <= st_hi; st += 2) {
        if (st + 2 <= st_hi) AT_LOAD(st + 2, ka, va);
        AT_COMPUTE(sb0, st);
        if (st + 1 <= st_hi) AT_STORE(sb1, kb, vb);
        LBAR();
        if (st + 1 > st_hi) break;
        if (st + 3 <= st_hi) AT_LOAD(st + 3, kb, vb);
        AT_COMPUTE(sb1, st + 1);
        if (st + 2 <= st_hi) AT_STORE(sb0, ka, va);
        LBAR();
    }
#undef AT_LOAD
#undef AT_STORE
#undef AT_COMPUTE
    lrun += __shfl_xor(lrun, 16); lrun += __shfl_xor(lrun, 32);
    const float inv = lrun > 0.f ? 1.f / lrun : 0.f;
#pragma unroll
    for (int dt = 0; dt < 4; ++dt) o[dt] *= inv;
}

constexpr int AL_CK = 77824, CKP = 144, AL_CV = AL_CK + 128 * CKP, CVP = 272;
constexpr int AL_BIAS = 0, AL_IMPA = 2048, AL_IMPB = AL_IMPA + 16384, AL_IMPT = AL_IMPB + 16384, AL_SELM = AL_IMPT + 4096;
__device__ __forceinline__ void attn_unit(int bg, int pb, bool build, const bf16* Q, const bf16* KV, const bf16* KCN, const bf16* VCT, const float* GATES, const float* rel_bias, bf16* A, unsigned char* lds) {
    int tid_ = threadIdx.x; OPQ_V(tid_); const int tid = tid_, lane = tid & 63, w = __builtin_amdgcn_readfirstlane(tid >> 6), qi = lane & 15, q4 = lane >> 4;
    const int hl = w & 3, half = w >> 2, b = bg >> 2, g = bg & 3, head = g * 4 + hl;
    const int p0 = pb * 32 + half * 16, t = p0 + qi; const size_t tok = (size_t)b * 2048 + t;
    float* biasT = (float*)(lds + AL_BIAS); float* impA = (float*)(lds + AL_IMPA); float* impB = (float*)(lds + AL_IMPB); float* impT = (float*)(lds + AL_IMPT); unsigned* selw = (unsigned*)(lds + AL_SELM);
    const bf16x8 qf0 = *(const bf16x8*)(Q + tok * 1024 + head * 64 + q4 * 8), qf1 = *(const bf16x8*)(Q + tok * 1024 + head * 64 + 32 + q4 * 8);
    const float g0 = GATES[tok * 48 + head * 3 + 0], g1 = GATES[tok * 48 + head * 3 + 1], g2 = GATES[tok * 48 + head * 3 + 2];
    if (tid < 32) selw[tid] = 0u;
    if (build) {
        const int h_ = tid >> 7, d_ = tid & 127; if (d_ < BIAS_N) biasT[h_ * 128 + d_] = rel_bias[t5_bucket(d_) * 16 + g * 4 + h_] * LOG2E;
#pragma unroll
        for (int i = 0; i < 2; ++i) { const int id = tid + 512 * i, row = id >> 3, ch = id & 7;
            *(u32x4*)(lds + AL_CK + row * CKP + ch * 16) = *(const u32x4*)(KCN + ((size_t)bg * 128 + row) * 64 + ch * 8); }
#pragma unroll
        for (int i = 0; i < 2; ++i) { const int id = tid + 512 * i, row = id >> 4, ch = id & 15;
            *(u32x4*)(lds + AL_CV + row * CVP + ch * 16) = *(const u32x4*)(VCT + ((size_t)bg * 64 + row) * 128 + ch * 8); }
        __syncthreads();
    }
    const float* bias = biasT + hl * 128; const float cfar = bias[BIAS_N - 1];
    f32x4 acc[4];
    {
        const int nst = (2 * pb + 1 + 31) >> 5;
        float pc[4][2][4];
#pragma unroll
        for (int st = 0; st < 4; ++st)
#pragma unroll
            for (int ph = 0; ph < 2; ++ph)
#pragma unroll
                for (int j = 0; j < 4; ++j) pc[st][ph][j] = NEGF;
        float mx = NEGF;
#pragma unroll
        for (int st = 0; st < 4; ++st) if (st < nst) {
#pragma unroll
            for (int ph = 0; ph < 2; ++ph) {
                const bf16* kp = (const bf16*)(lds + AL_CK + (st * 32 + ph * 16 + qi) * CKP) + q4 * 8;
                const bf16x8 a0 = *(const bf16x8*)kp, a1 = *(const bf16x8*)(kp + 32);
                f32x4 s = {0.f, 0.f, 0.f, 0.f};
                s = __builtin_amdgcn_mfma_f32_16x16x32_bf16(a0, qf0, s, 0, 0, 0); s = __builtin_amdgcn_mfma_f32_16x16x32_bf16(a1, qf1, s, 0, 0, 0);
#pragma unroll
                for (int j = 0; j < 4; ++j) {
                    const int c = st * 32 + ph * 16 + q4 * 4 + j, dist = t - (16 * c + 31);
                    const int bi = dist < 0 ? 0 : (dist > BIAS_N - 1 ? BIAS_N - 1 : dist);
                    const float l = s[j] * SC2 + bias[bi];
                    if (dist >= 0) { pc[st][ph][j] = l; mx = fmaxf(mx, l); }
                }
            }
        }
        mx = fmaxf(mx, __shfl_xor(mx, 16)); mx = fmaxf(mx, __shfl_xor(mx, 32));
        float sum = 0.f;
#pragma unroll
        for (int st = 0; st < 4; ++st)
#pragma unroll
            for (int ph = 0; ph < 2; ++ph)
#pragma unroll
                for (int j = 0; j < 4; ++j) { const float p = pc[st][ph][j] > -1e29f ? __builtin_amdgcn_exp2f(pc[st][ph][j] - mx) : 0.f; pc[st][ph][j] = p; sum += p; }
        sum += __shfl_xor(sum, 16); sum += __shfl_xor(sum, 32);
        const float inv = sum > 0.f ? 1.f / sum : 0.f;
        f32x4 oc[4];
#pragma unroll
        for (int dt = 0; dt < 4; ++dt) oc[dt] = (f32x4){0.f, 0.f, 0.f, 0.f};
        const int prow = (hl * 32 + half * 16 + qi) * 32;
#pragma unroll
        for (int st = 0; st < 4; ++st) {
#pragma unroll
            for (int ph = 0; ph < 2; ++ph) {
#pragma unroll
                for (int j = 0; j < 4; ++j) pc[st][ph][j] *= inv;
                const int jj = st * 8 + ph * 4 + q4;
                impA[prow + jj] = pc[st][ph][0] + pc[st][ph][1] + pc[st][ph][2] + 0.5f * pc[st][ph][3];
                impB[prow + jj] = 0.5f * pc[st][ph][3];
            }
            if (st < nst) {
                const bf16x8 pf = pack_p(pc[st][0], pc[st][1]);
#pragma unroll
                for (int dt = 0; dt < 4; ++dt) { const bf16x8 vf = ldv((const bf16*)(lds + AL_CV + (dt * 16 + qi) * CVP) + st * 32 + q4 * 4); oc[dt] = __builtin_amdgcn_mfma_f32_16x16x32_bf16(vf, pf, oc[dt], 0, 0, 0); }
            }
        }
#pragma unroll
        for (int dt = 0; dt < 4; ++dt) acc[dt] = oc[dt] * g0;
    }
    __syncthreads();
    for (int idx = tid; idx < 1024; idx += 512) {
        const int pos = idx >> 5, j = idx & 31; float s = 0.f;
#pragma unroll
        for (int h = 0; h < 4; ++h) s += impA[(h * 32 + pos) * 32 + j] + (j > 0 ? impB[(h * 32 + pos) * 32 + j - 1] : 0.f);
        impT[idx] = s;
    }
    __syncthreads();
    {
        const int cur = pb >> 1, pos = tid >> 4;
        float iv[32];
#pragma unroll
        for (int q = 0; q < 8; ++q) { const f32x4 v4 = *(const f32x4*)(impT + pos * 32 + 4 * q); iv[4 * q] = v4.x; iv[4 * q + 1] = v4.y; iv[4 * q + 2] = v4.z; iv[4 * q + 3] = v4.w; }
        unsigned bits = 0u;
#pragma unroll
        for (int h2 = 0; h2 < 2; ++h2) {
            const int jj = (tid & 15) + 16 * h2;
            bool sel = false;
            if (jj <= cur) {
                if (jj == 0 || jj == cur || jj == cur - 1) sel = true;
                else {
                    float v = 0.f;
#pragma unroll
                    for (int j2 = 0; j2 < 32; ++j2) v = (j2 == jj) ? iv[j2] : v;
                    int cnt = 3;
#pragma unroll
                    for (int j2 = 1; j2 < 30; ++j2) cnt += (j2 <= cur - 2) && (j2 != jj) && ((iv[j2] > v) || (iv[j2] == v && j2 < jj));
                    sel = cnt < 16;
                }
            }
            if (sel) bits |= 1u << jj;
        }
        if (bits) atomicOr(&selw[pos], bits);
    }
    __syncthreads();
    const unsigned selm = selw[half * 16 + qi];
    {
        f32x4 o[4];
        attn_stream<0>(KV + 2 * KV_ELEMS + (size_t)bg * 2048 * 64, KV + 3 * KV_ELEMS + (size_t)bg * 64 * 2048, qf0, qf1, t, p0, pb, selm, bias, cfar, o, qi, q4, tid, lds);
#pragma unroll
        for (int dt = 0; dt < 4; ++dt) acc[dt] += o[dt] * g1;
    }
    {
        f32x4 o[4];
        attn_stream<1>(KV + 4 * KV_ELEMS + (size_t)bg * 2048 * 64, KV + 5 * KV_ELEMS + (size_t)bg * 64 * 2048, qf0, qf1, t, p0, pb, 0u, bias, cfar, o, qi, q4, tid, lds);
#pragma unroll
        for (int dt = 0; dt < 4; ++dt) acc[dt] += o[dt] * g2;
    }
#pragma unroll
    for (int dt = 0; dt < 4; ++dt) {
        u32x2 pk; pk.x = cvtpk(acc[dt][0], acc[dt][1]); pk.y = cvtpk(acc[dt][2], acc[dt][3]);
        *(u32x2*)(A + tok * 1024 + head * 64 + dt * 16 + q4 * 4) = pk;
    }
    __syncthreads();
}

#define GAS __attribute__((address_space(1)))

#define RLX_AGENT __ATOMIC_RELAXED, __HIP_MEMORY_SCOPE_AGENT
#define XB_TMO      128
#define XB_XCNT(j)  (256  + 64 * (j))
#define XB_XSUB(j)  (1280 + 64 * (j))
#define XB_XGEN(j)  (2304 + 64 * (j))
#define XB_TOP      3328
#define XB_TOPGEN   3392
#define XCD_BAR_WORDS 3456
#define XB_SPIN_CAP (1u << 18)

__device__ __forceinline__ unsigned xb_ld(unsigned* p)              { return __hip_atomic_load(p, __ATOMIC_RELAXED, __HIP_MEMORY_SCOPE_AGENT); }
__device__ __forceinline__ unsigned xb_add(unsigned* p, unsigned v) { return __hip_atomic_fetch_add(p, v, __ATOMIC_RELAXED, __HIP_MEMORY_SCOPE_AGENT); }
__device__ __forceinline__ unsigned xb_xcc_id() { return (unsigned)__builtin_amdgcn_s_getreg((3 << 11) | 20) & 0xFu; }
#define XB_SPIN(cond, bar) do { unsigned _sp = 0; while (cond) { __builtin_amdgcn_s_sleep(1); \
    if ((++_sp & 255u) == 0u) { if (xb_ld(&(bar)[XB_TMO])) break; if (_sp > XB_SPIN_CAP) { atomicAdd(&(bar)[XB_TMO], 1u); break; } } } } while (0)

struct XcdBarrier {
    unsigned* bar; unsigned x;
    volatile LAS unsigned* st;
};

__device__ __forceinline__ XcdBarrier xcd_barrier_post(unsigned* bar, volatile LAS unsigned* st) {
    XcdBarrier b; b.bar = bar; b.x = xb_xcc_id(); b.st = st;
    if (threadIdx.x == 0) (void)xb_add(&bar[XB_XCNT(b.x)], 1u);
    return b;
}
__device__ __forceinline__ void xcd_barrier_complete(unsigned* bar, unsigned x, unsigned& nloc, unsigned& nx) {
    const unsigned G = gridDim.x * gridDim.y * gridDim.z;
    unsigned sum, cnt, mine, sp = 0u;
    for (;;) {
        sum = 0u; cnt = 0u; mine = 0u;
#pragma unroll
        for (unsigned j = 0; j < 16; ++j) { const unsigned c = xb_ld(&bar[XB_XCNT(j)]); sum += c; cnt += (c > 0u) ? 1u : 0u; mine = (j == x) ? c : mine; }
        if (sum == G) break;
        __builtin_amdgcn_s_sleep(1);
        if ((++sp & 255u) == 0u) { if (xb_ld(&bar[XB_TMO])) break; if (sp > XB_SPIN_CAP) { atomicAdd(&bar[XB_TMO], 1u); break; } }
    }
    nloc = mine > 0u ? mine : 1u; nx = cnt > 0u ? cnt : 1u;
}

__device__ __forceinline__ void xcd_barrier(const XcdBarrier& b) {
    asm volatile("s_waitcnt vmcnt(0)" ::: "memory");
    __syncthreads();
    if (threadIdx.x == 0) {
        unsigned* bar = b.bar;
        __builtin_amdgcn_s_waitcnt(0);
        unsigned nloc = b.st[0], nx = b.st[1];
        if (nloc == 0u) { xcd_barrier_complete(bar, b.x, nloc, nx); b.st[0] = nloc; b.st[1] = nx; }
        const unsigned old = xb_add(&bar[XB_XSUB(b.x)], 1u);
        const unsigned gen = old / nloc;
        if (old + 1u == (gen + 1u) * nloc) {
            __builtin_amdgcn_fence(__ATOMIC_RELEASE, "agent");
            asm volatile("s_waitcnt vmcnt(0)" ::: "memory");
            const unsigned og = xb_add(&bar[XB_TOP], 1u);
            const unsigned tg = og / nx;
            if (og + 1u == (tg + 1u) * nx) xb_add(&bar[XB_TOPGEN], 1u);
            else XB_SPIN(xb_ld(&bar[XB_TOPGEN]) == tg, bar);
            __builtin_amdgcn_fence(__ATOMIC_ACQUIRE, "agent");
            xb_add(&bar[XB_XGEN(b.x)], 1u);
            asm volatile("s_waitcnt vmcnt(0)" ::: "memory");
        } else {
            XB_SPIN(xb_ld(&bar[XB_XGEN(b.x)]) == gen, bar);
            __builtin_amdgcn_fence(__ATOMIC_ACQUIRE, "agent");
            asm volatile("s_waitcnt vmcnt(0)" ::: "memory");
        }
    }
    __syncthreads();
}

__global__ void __launch_bounds__(512, 2) fwd_megakernel(Args args) {
    extern __shared__ __attribute__((aligned(16))) unsigned char lds[];
    cg::grid_group grid = cg::this_grid();
    const int G = gridDim.x, bx = blockIdx.x;
    PG8_LAS unsigned char* ring = (PG8_LAS unsigned char*)lds;
    { volatile LAS unsigned* bst = (volatile LAS unsigned*)(lds_base() + (LDS_BYTES - 64));
      if (threadIdx.x < 2) bst[threadIdx.x] = 0u;
      if (bx == 0) { unsigned* barw = (unsigned*)(args.ws + WS_BAR); for (int i = threadIdx.x; i < BARW_TOTAL; i += 512) barw[i] = 0u; } }

    {
        unsigned char* ws = args.ws;
        int tid_ = threadIdx.x; OPQ_V(tid_); const int tid = tid_, lane = tid & 63, wave = __builtin_amdgcn_readfirstlane(tid >> 6);
        const int gw = bx * 8 + wave, NGW = G * 8;
        LAS float* scr = (LAS float*)((LAS unsigned char*)lds + wave * 16640);
#pragma unroll 1
        for (int l = 0; l < NLAYER; ++l) {
            unsigned char* lw = ws + (size_t)l * LW_BYTES;
            conv_set(CV_ARGS(args), ws, l, l == 0 ? (CV_GU1 | CV_D1 | CV_WIN) : CV_D1, scr, gw, NGW, lane);
            { const float* sw = args.in[18] + (size_t)l * 8 * 128 * 128; bf16* dw = (bf16*)(lw + LW_SGW);
              for (int i = bx * 512 + tid; i < 8 * 128 * 128; i += G * 512) { const int tt = (i >> 7) & 127, ss = i & 127; dw[i] = ss <= tt ? f2bf(sw[i]) : (bf16)0; } }
            { float* par = (float*)(lw + LW_PAR);
              for (int i = bx * 512 + tid; i < PAR_FLOATS; i += G * 512) {
                  float v;
                  if (i < PAR_KN) v = args.in[8][l * 64 + i];
                  else if (i < PAR_SGG) v = args.in[9][l * 192 + i - PAR_KN];
                  else if (i < PAR_SGB) v = args.in[16][l * 1024 + i - PAR_SGG];
                  else if (i < PAR_SGBS) v = args.in[17][l * 1024 + i - PAR_SGB];
                  else if (i < PAR_N1) v = args.in[19][l * 1024 + i - PAR_SGBS];
                  else if (i < PAR_NM) v = args.in[2][l * 2048 + i - PAR_N1];
                  else if (i < PAR_N2) v = args.in[6][l * 2048 + i - PAR_NM];
                  else if (i < PAR_RELB) v = args.in[23][l * 2048 + i - PAR_N2];
                  else v = args.in[1][i - PAR_RELB];
                  par[i] = v;
              } }
        }
        __syncthreads();
        for (int it = bx; it < 64; it += G) {
            const int l = it >> 5, isv = (it >> 4) & 1, ng = it & 15, col = tid & 15, sl = tid >> 4;
            const float* pos = args.in[isv ? 11 : 10] + (size_t)l * 2048 + sl * 64; const float* w1 = args.in[isv ? 14 : 12] + (size_t)l * 2048 * 256 + (size_t)sl * 64 * 256 + ng * 16 + col;
            float a = 0.f;
#pragma unroll 16
            for (int k = 0; k < 64; ++k) a += pos[k] * w1[(size_t)k * 256];
            float* part = (float*)lds; part[sl * 16 + col] = a;
            __syncthreads();
            if (tid < 16) { float s = 0.f;
#pragma unroll
                for (int s2 = 0; s2 < 32; ++s2) s += part[s2 * 16 + tid];
                ((float*)(ws + (size_t)l * LW_BYTES + LW_B1))[isv * 256 + ng * 16 + tid] = s; }
            __syncthreads();
        }
        for (int m = gw; m < M; m += NGW) prep_row(args.in[0] + (size_t)m * D, (bf16*)(ws + WS_H) + (size_t)m * D, (bf16*)(ws + WS_L) + (size_t)m * D, (float*)(ws + WS_SS) + (size_t)m * 8, lane);
    }
    grid.sync();
    (void)xcd_barrier_post((unsigned*)(args.ws + WS_BAR), (volatile LAS unsigned*)(lds_base() + (LDS_BYTES - 64)));

#pragma unroll 1
    for (int step = 0; step < 9 * NLAYER; ++step) {
        const int l = step / 9, k = step - l * 9;
        unsigned char* ws = args.ws; OPQ_P(ws); unsigned char* lw = ws + (size_t)l * LW_BYTES;
        if (threadIdx.x < 8) ((LAS int*)(lds_base() + LDS_RSTAG))[threadIdx.x] = 0;
        if (k == 0 || k == 7) {
            pg8::Gemm g{(const bf16*)(ws + WS_H), (const bf16*)(lw + (k == 7 ? LW_GU2 : LW_GU1)), M, 2 * FF, D, D}; pg8::StaticOrder So; So.init(M, 2 * FF, G, bx);
            EpiSwiGLU E{ws};
            pg8::gemm_phase<EpiSwiGLU, pg8::StaticOrder, true, true>(ring, g, So, E);
        } else if (k == 1 || k == 8 || k == 6) {
            const bool isout = k == 6;
            pg8::Gemm g{(const bf16*)(ws + (isout ? WS_MRG : WS_HFF)), (const bf16*)(lw + (isout ? LW_O : (k == 8 ? LW_D2 : LW_D1))), M, D, isout ? D : FF, isout ? D : FF}; pg8::StaticOrder So; So.init(M, D, G, bx);
            EpiResid E{args.out, ws, isout ? 1.0f : 0.5f, step == 9 * NLAYER - 1 ? 1 : 0};
            pg8::gemm_phase<EpiResid, pg8::StaticOrder, true, true>(ring, g, So, E);
        } else if (k == 2) {
            pg8::Gemm g{(const bf16*)(ws + WS_H), (const bf16*)(lw + LW_IN), M, INP, D, D}; pg8::StaticOrder So; So.init(M, INP, G, bx);
            EpiIn E{ws, l};
            pg8::gemm_phase<EpiIn, pg8::StaticOrder, true, true>(ring, g, So, E);
        } else if (k == 3) {
            const float* par = (const float*)(lw + LW_PAR);
            if (G == 256) cs_pair(bx, bx, bx + 256, (const bf16*)(ws + WS_KV), (const bf16*)(lw + LW_C1K), (const bf16*)(lw + LW_C1V), (const bf16*)(lw + LW_C2K), (const bf16*)(lw + LW_C2V), (const float*)(lw + LW_B1),
                                  par + PAR_KN, (bf16*)(ws + WS_KCN), (bf16*)(ws + WS_VCT), (const bf16*)(ws + WS_U), (const bf16*)(ws + WS_V), (const float*)(ws + WS_VSTAT), par + PAR_SGG, par + PAR_SGB,
                                  (const bf16*)(lw + LW_SGW), par + PAR_SGBS, (bf16*)(ws + WS_SG), lds);
            else
            for (int u = bx; u < 768; u += G) {
                if (u < 256) compress_unit(u, (const bf16*)(ws + WS_KV), (const bf16*)(lw + LW_C1K), (const bf16*)(lw + LW_C1V), (const bf16*)(lw + LW_C2K), (const bf16*)(lw + LW_C2V), (const float*)(lw + LW_B1),
                                           par + PAR_KN, (bf16*)(ws + WS_KCN), (bf16*)(ws + WS_VCT), lds);
                else sgu_unit(u - 256, (const bf16*)(ws + WS_U), (const bf16*)(ws + WS_V), (const float*)(ws + WS_VSTAT), par + PAR_SGG, par + PAR_SGB,
                              (const bf16*)(lw + LW_SGW), par + PAR_SGBS, (bf16*)(ws + WS_SG), lds);
            }
        } else if (k == 4) {
            const float* par = (const float*)(lw + LW_PAR);
            int last_bg = -1;
            for (int u = bx; u < 1024; u += G) {
                const int r = u >> 8, wq = u & 255, slot = wq >> 3, i = slot & 15, bg = (wq & 7) * 2 + (slot >> 4);
                const int pb = r == 0 ? 63 - i : (r == 1 ? 32 + i : (r == 2 ? 31 - i : i));
                const bool build = bg != last_bg; last_bg = bg;
                attn_unit(bg, pb, build, (const bf16*)(ws + WS_Q), (const bf16*)(ws + WS_KV), (const bf16*)(ws + WS_KCN), (const bf16*)(ws + WS_VCT), (const float*)(ws + WS_GATES), par + PAR_RELB, (bf16*)(ws + WS_A), lds);
            }
            __syncthreads();
        } else {
            pg8::Gemm g{(const bf16*)(ws + WS_SG), (const bf16*)(lw + LW_PS), M, D, 1024, 1024, (const bf16*)(ws + WS_A), (const bf16*)(lw + LW_PN)};
            pg8::TwoKinds S2; S2.so.init(M, D, G, bx);
            EpiTM E{ws};
            pg8::gemm_phase<EpiTM, pg8::TwoKinds, true, true>(ring, g, S2, E);
        }
        {
            unsigned tmask = 0u; int tl = l;
            if (k == 0) tmask = l == 0 ? (CV_SMALL | CV_D2) : (CV_SMALL | CV_WIN);
            else if (k == 2) tmask = CV_GU2;
            else if (k == 7) { if (l == 0) { tl = 1; tmask = CV_GU1; } else tmask = CV_D2; }
            if (tmask) {
                const int nleft = ((M / 256) * ((k == 2 ? INP : 2 * FF) / 256)) % G;
                if (bx >= nleft) {
                    __syncthreads();
                    int tid_ = threadIdx.x; OPQ_V(tid_); const int lane = tid_ & 63, wave = __builtin_amdgcn_readfirstlane(tid_ >> 6);
                    LAS float* scr = (LAS float*)(lds_base() + wave * 16640);
                    unsigned char* ws2 = args.ws; OPQ_P(ws2);
                    conv_set(CV_ARGS(args), ws2, tl, tmask, scr, (bx - nleft) * 8 + wave, (G - nleft) * 8, lane);
                }
            }
        }
        if (step < 9 * NLAYER - 1) { XcdBarrier xb_; xb_.bar = (unsigned*)(args.ws + WS_BAR); xb_.x = xb_xcc_id(); xb_.st = (volatile LAS unsigned*)(lds_base() + (LDS_BYTES - 64)); xcd_barrier(xb_); }
    }
}

extern "C" void kernel_launch(void* const* d_in, const int* in_sizes, int n_in, void* d_out, int out_size, void* d_ws, size_t ws_size, hipStream_t stream) {
    static int grid = 0;
    if (grid == 0) {
        if (n_in != 27 || out_size != M * D || ws_size < WS_END) { fprintf(stderr, "kernel_launch: unexpected problem (n_in %d out %d ws %zu need %zu)\n", n_in, out_size, ws_size, (size_t)WS_END); grid = -1; return; }
        int dev = 0, cus = 0, per_cu = 0;
        (void)hipGetDevice(&dev);
        (void)hipDeviceGetAttribute(&cus, hipDeviceAttributeMultiprocessorCount, dev);
        (void)hipFuncSetAttribute((const void*)fwd_megakernel, hipFuncAttributeMaxDynamicSharedMemorySize, LDS_BYTES);
        (void)hipOccupancyMaxActiveBlocksPerMultiprocessor(&per_cu, (const void*)fwd_megakernel, 512, LDS_BYTES);
        if (per_cu < 1) per_cu = 1;
        grid = cus * per_cu;
        fprintf(stderr, "kernel_launch: grid %d (cus %d x %d), ws %zu need %zu\n", grid, cus, per_cu, ws_size, (size_t)WS_END);
    }
    if (grid < 0) return;
    Args a{};
    for (int i = 0; i < 27; ++i) a.in[i] = (const float*)d_in[i];
    a.out = (float*)d_out; a.ws = (unsigned char*)d_ws;
    void* kargs[] = {&a};
    hipError_t e = hipLaunchCooperativeKernel((const void*)fwd_megakernel, dim3(grid), dim3(512), kargs, LDS_BYTES, stream);
    if (e != hipSuccess) fprintf(stderr, "kernel_launch: cooperative launch failed: %s (grid %d)\n", hipGetErrorString(e), grid);
}
```

```cpp
#include <hip/hip_runtime.h>
#include <hip/hip_cooperative_groups.h>
#include <cstdio>
#include <cstdint>
namespace cg = cooperative_groups;
namespace pg8 {
#define PG8_LAS __attribute__((address_space(3)))
typedef unsigned short bf16_t;
typedef short bf16x8 __attribute__((ext_vector_type(8)));
typedef float f32x4 __attribute__((ext_vector_type(4)));
typedef unsigned u32x4 __attribute__((ext_vector_type(4)));
constexpr int BM = 256, BK = 64, HALF = 128, HTB = HALF * BK * 2  , STAGE_BYTES = 8 * HTB, NXCD = 8, WGM = 4;

__host__ __device__ __forceinline__ int lds_byte(int r, int c) { const int st = (r >> 4) * 2 + (c >> 5), rr = r & 15, cc = c & 31, ob = rr * 64 + cc * 2; return st * 1024 + (ob ^ (((ob >> 9) & 1) << 5)); }
__host__ __device__ __forceinline__ void stage_rc(int b, int& R, int& C) { const int st = b / 1024, sb = b % 1024, swz = sb ^ (((sb >> 9) & 1) << 5); R = (st >> 1) * 16 + swz / 64; C = (st & 1) * 32 + (swz % 64) / 2; }
__host__ __device__ __forceinline__ int perm32(int rho) { const int n = rho >> 4, i = rho & 15; return 8 * (i >> 2) + 4 * n + (i & 3); }

struct Unit { int pm, pn, kind; };
struct Gemm { const bf16_t* A; const bf16_t* Bt; int M, N, K, ld; const bf16_t* A2; const bf16_t* Bt2; };

struct StaticOrder {
    int nM, nN, nwg, G, c, lim;
    __host__ __device__ __forceinline__ void init(int M, int N, int G_, int c_) { nM = M / BM; nN = N / BM; nwg = nM * nN; G = G_; c = c_; lim = nwg; }
    __host__ __device__ __forceinline__ bool next(int i, Unit& u) const {
        const long L = (long)i * G + c; if (L >= lim) return false;
        tile_of((int)L, u); return true;
    }
    __host__ __device__ __forceinline__ void tile_of(int L_, Unit& u) const {
        const long L = L_;
        int wgid = (int)L; { const int q = nwg / NXCD, r = nwg % NXCD, xcd = wgid % NXCD, off = wgid / NXCD; wgid = (xcd < r ? xcd * (q + 1) : r * (q + 1) + (xcd - r) * q) + off; }
        const int nig = WGM * nN, gid = wgid / nig, fm = gid * WGM, gsz = (nM - fm) < WGM ? (nM - fm) : WGM;
        u.pm = fm + ((wgid % nig) % gsz); u.pn = (wgid % nig) / gsz; u.kind = 0;
    }
    __device__ __forceinline__ void a_ready(const Unit&) const {}
    __device__ __forceinline__ void done(const Unit&) const {}
};
struct TwoKinds {
    StaticOrder so;
    __device__ __forceinline__ bool next(int i, Unit& u) const { if (!so.next(i >> 1, u)) return false; u.kind = i & 1; return true; }
    __device__ __forceinline__ void a_ready(const Unit&) const {}
    __device__ __forceinline__ void done(const Unit&) const {}
};
struct OneUnit {
    Unit u0;
    __device__ __forceinline__ bool next(int i, Unit& u) const { if (i != 0) return false; u = u0; return true; }
    __device__ __forceinline__ void a_ready(const Unit&) const {}
    __device__ __forceinline__ void done(const Unit&) const {}
};

__device__ __forceinline__ unsigned cvt_pk_bf16(float lo, float hi) { unsigned r; asm volatile("v_cvt_pk_bf16_f32 %0, %1, %2" : "=v"(r) : "v"(lo), "v"(hi)); return r; }
typedef float f32x2 __attribute__((ext_vector_type(2)));
template <class Epi, class Sched, bool ALIGN_EPI = false, bool SP2 = false>
__device__ __forceinline__ void gemm_phase(PG8_LAS unsigned char* lds, const Gemm g, const Sched& S, const Epi& E) {
    int tid_ = threadIdx.x; asm volatile("" : "+v"(tid_)); const int tid = tid_, wid = __builtin_amdgcn_readfirstlane(tid >> 6), lane = tid & 63, wr = wid >> 2, wc = wid & 3, fr = lane & 15, fq = lane >> 4;
    const int K = g.ld, nt = g.K / BK;
    unsigned voffA[2], voffB[2];
#pragma unroll
    for (int i = 0; i < 2; ++i) { int R, C; stage_rc(tid * 16 + i * 8192, R, C); const int Rb = Epi::PERM ? ((R & ~31) + perm32(R & 31)) : R;
        voffA[i] = (unsigned)(R * K + C) * 2u; voffB[i] = (unsigned)(Rb * K + C) * 2u; }
    const size_t kstep = (size_t)(BK * 2);
    const size_t hstep = (size_t)HALF * K * 2;
    const size_t tstep = 2 * hstep;
    const unsigned ldsw = (unsigned)wid * 1024u;
    const int aoff = lds_byte(wr * 64 + fr, fq * 8), boff = lds_byte(wc * 32 + fr, fq * 8);
#define PG8_SA(b, h) (((b) * 2 + (h)) * HTB)
#define PG8_SB(b, h) ((4 + (b) * 2 + (h)) * HTB)
#define PG8_STAGE(bufoff, gbase, voff) do { _Pragma("unroll") for (int _i = 0; _i < 2; ++_i) \
        __builtin_amdgcn_global_load_lds((const unsigned*)((const char*)(gbase) + (voff)[_i]), (PG8_LAS unsigned*)(lds + (bufoff) + ldsw + _i * 8192), 16, 0, 0); } while (0)
#define PG8_LDA(dst, b, h) do { _Pragma("unroll") for (int m = 0; m < 4; ++m) _Pragma("unroll") for (int k = 0; k < 2; ++k) dst[m][k] = *(const PG8_LAS bf16x8*)(lds + PG8_SA(b, h) + aoff + m * 2048 + k * 1024); } while (0)
#define PG8_LDB(dst, b, h) do { _Pragma("unroll") for (int n = 0; n < 2; ++n) _Pragma("unroll") for (int k = 0; k < 2; ++k) dst[n][k] = *(const PG8_LAS bf16x8*)(lds + PG8_SB(b, h) + boff + n * 2048 + k * 1024); } while (0)
#define PG8_MMA(ai, bj, At, Bt) do { __builtin_amdgcn_s_setprio(1); _Pragma("unroll") for (int m = 0; m < 4; ++m) _Pragma("unroll") for (int n = 0; n < 2; ++n) _Pragma("unroll") for (int k = 0; k < 2; ++k) \
        acc[ai][bj][m][n] = __builtin_amdgcn_mfma_f32_16x16x32_bf16(Bt[n][k], At[m][k], acc[ai][bj][m][n], 0, 0, 0); __builtin_amdgcn_s_setprio(0); } while (0)
#define PG8_WAIT_V(n) asm volatile("s_waitcnt vmcnt(" #n ")" ::: "memory")
#define PG8_WAIT_L(n) asm volatile("s_waitcnt lgkmcnt(" #n ")" ::: "memory")
#define PG8_BAR __builtin_amdgcn_s_barrier()
#define PG8_SCHED __builtin_amdgcn_sched_barrier(0)
    Unit cur, nxt; int ui = 0;
    if (!S.next(0, cur)) return;
    f32x4 acc[2][2][4][2];
#pragma unroll
    for (int a = 0; a < 2; ++a)
#pragma unroll
        for (int b = 0; b < 2; ++b)
#pragma unroll
            for (int m = 0; m < 4; ++m)
#pragma unroll
                for (int n = 0; n < 2; ++n) acc[a][b][m][n] = (f32x4){0.f, 0.f, 0.f, 0.f};
    bf16x8 At[4][2], B0[2][2], B1[2][2];
    const char* cA = (const char*)(cur.kind ? g.A2 : g.A) + (size_t)cur.pm * tstep; const char* cB = (const char*)(cur.kind ? g.Bt2 : g.Bt) + (size_t)cur.pn * tstep;
    S.a_ready(cur);
    if constexpr (SP2) {
        PG8_STAGE(PG8_SB(0, 0), cB, voffB); PG8_STAGE(PG8_SB(0, 1), cB + hstep, voffB); PG8_STAGE(PG8_SA(0, 0), cA, voffA); PG8_STAGE(PG8_SA(0, 1), cA + hstep, voffA);
        if (wr == 1) PG8_BAR;
        PG8_WAIT_V(2); PG8_BAR;
        PG8_STAGE(PG8_SB(1, 0), cB + kstep, voffB); PG8_STAGE(PG8_SA(1, 0), cA + kstep, voffA); PG8_STAGE(PG8_SB(1, 1), cB + hstep + kstep, voffB);
        PG8_WAIT_V(6); PG8_BAR;
    } else {
        PG8_STAGE(PG8_SB(0, 0), cB, voffB); PG8_STAGE(PG8_SA(0, 0), cA, voffA); PG8_STAGE(PG8_SB(0, 1), cB + hstep, voffB); PG8_STAGE(PG8_SA(0, 1), cA + hstep, voffA);
        if (wr == 1) PG8_BAR;
        PG8_WAIT_V(4); PG8_BAR;
        PG8_STAGE(PG8_SB(1, 0), cB + kstep, voffB); PG8_STAGE(PG8_SA(1, 0), cA + kstep, voffA); PG8_STAGE(PG8_SB(1, 1), cB + hstep + kstep, voffB);
        PG8_WAIT_V(6); PG8_BAR;
    }
    for (;;) {
        const bool has_next = S.next(ui + 1, nxt);
        const char* nA = has_next ? (const char*)(nxt.kind ? g.A2 : g.A) + (size_t)nxt.pm * tstep : cA; const char* nB = has_next ? (const char*)(nxt.kind ? g.Bt2 : g.Bt) + (size_t)nxt.pn * tstep : cB;
        for (int t = 0; t < nt; t += 2) {
            const bool last = (t == nt - 2);
            const char* a1 = cA + (size_t)(t + 1) * kstep;
            const char* a2 = last ? nA : cA + (size_t)(t + 2) * kstep; const char* b2 = last ? nB : cB + (size_t)(t + 2) * kstep;
            const char* a3 = a2 + kstep; const char* b3 = b2 + kstep;
            if (last && has_next) S.a_ready(nxt);
            if constexpr (SP2) {
            PG8_LDB(B0, 0, 0); PG8_LDB(B1, 0, 1); PG8_SCHED; PG8_LDA(At, 0, 0); PG8_STAGE(PG8_SA(1, 1), a1 + hstep, voffA);
            PG8_WAIT_V(8); PG8_WAIT_L(0); PG8_BAR; PG8_MMA(0, 0, At, B0); PG8_MMA(0, 1, At, B1); PG8_BAR; PG8_SCHED;
            PG8_LDA(At, 0, 1); PG8_STAGE(PG8_SB(0, 0), b2, voffB); PG8_STAGE(PG8_SB(0, 1), b2 + hstep, voffB); PG8_STAGE(PG8_SA(0, 0), a2, voffA);
            PG8_WAIT_V(8); PG8_WAIT_L(0); PG8_BAR; PG8_MMA(1, 0, At, B0); PG8_MMA(1, 1, At, B1); PG8_BAR; PG8_SCHED;
            PG8_LDB(B0, 1, 0); PG8_LDB(B1, 1, 1); PG8_SCHED; PG8_LDA(At, 1, 0); PG8_STAGE(PG8_SA(0, 1), a2 + hstep, voffA);
            PG8_WAIT_V(8); PG8_WAIT_L(0); PG8_BAR; PG8_MMA(0, 0, At, B0); PG8_MMA(0, 1, At, B1); PG8_BAR; PG8_SCHED;
            PG8_LDA(At, 1, 1); PG8_STAGE(PG8_SB(1, 0), b3, voffB); PG8_STAGE(PG8_SB(1, 1), b3 + hstep, voffB); PG8_STAGE(PG8_SA(1, 0), a3, voffA);
            PG8_WAIT_V(8); PG8_WAIT_L(0); PG8_BAR; PG8_MMA(1, 0, At, B0); PG8_MMA(1, 1, At, B1); PG8_BAR; PG8_SCHED;
            } else {
            PG8_LDB(B0, 0, 0); PG8_SCHED; PG8_LDA(At, 0, 0); PG8_STAGE(PG8_SA(1, 1), a1 + hstep, voffA);
            PG8_WAIT_L(8); PG8_BAR; PG8_WAIT_L(0); PG8_MMA(0, 0, At, B0); PG8_BAR; PG8_SCHED;
            PG8_LDB(B1, 0, 1); PG8_STAGE(PG8_SB(0, 0), b2, voffB);
            PG8_BAR; PG8_WAIT_L(0); PG8_MMA(0, 1, At, B1); PG8_BAR;
            PG8_LDA(At, 0, 1); PG8_STAGE(PG8_SA(0, 0), a2, voffA);
            PG8_BAR; PG8_WAIT_L(0); PG8_MMA(1, 0, At, B0); PG8_BAR; PG8_SCHED;
            PG8_STAGE(PG8_SB(0, 1), b2 + hstep, voffB);
            PG8_WAIT_V(6); PG8_BAR; PG8_MMA(1, 1, At, B1); PG8_BAR;
            PG8_LDB(B0, 1, 0); PG8_SCHED; PG8_LDA(At, 1, 0); PG8_STAGE(PG8_SA(0, 1), a2 + hstep, voffA);
            PG8_WAIT_L(8); PG8_BAR; PG8_WAIT_L(0); PG8_MMA(0, 0, At, B0); PG8_BAR; PG8_SCHED;
            PG8_LDB(B1, 1, 1); PG8_STAGE(PG8_SB(1, 0), b3, voffB);
            PG8_BAR; PG8_WAIT_L(0); PG8_MMA(0, 1, At, B1); PG8_BAR;
            PG8_LDA(At, 1, 1); PG8_STAGE(PG8_SA(1, 0), a3, voffA);
            PG8_BAR; PG8_WAIT_L(0); PG8_MMA(1, 0, At, B0); PG8_BAR; PG8_SCHED;
            PG8_STAGE(PG8_SB(1, 1), b3 + hstep, voffB);
            PG8_WAIT_V(6); PG8_BAR; PG8_MMA(1, 1, At, B1); PG8_BAR;
            }
        }
        if constexpr (ALIGN_EPI) { if (wr == 0) PG8_BAR; }
        if constexpr (!Epi::AFTER_DRAIN) { E(acc, cur, wr, wc, fr, fq); S.done(cur); }
        if (!has_next) break;
#pragma unroll
        for (int a = 0; a < 2; ++a)
#pragma unroll
            for (int b = 0; b < 2; ++b)
#pragma unroll
                for (int m = 0; m < 4; ++m)
#pragma unroll
                    for (int n = 0; n < 2; ++n) acc[a][b][m][n] = (f32x4){0.f, 0.f, 0.f, 0.f};
        cur = nxt; cA = nA; cB = nB; ++ui;
        if constexpr (ALIGN_EPI) { if (wr == 1) PG8_BAR; }
    }
    PG8_WAIT_V(0);
    if constexpr (!ALIGN_EPI) { if (wr == 0) PG8_BAR; }
    PG8_BAR;
    if constexpr (Epi::AFTER_DRAIN) { E.fused(acc, cur, wr, wc, fr, fq, lds, wid, lane); S.done(cur); }
#undef PG8_SA
#undef PG8_SB
#undef PG8_STAGE
#undef PG8_LDA
#undef PG8_LDB
#undef PG8_MMA
#undef PG8_WAIT_V
#undef PG8_WAIT_L
#undef PG8_BAR
#undef PG8_SCHED
}
}

constexpr int NB = 4, S = 2048, D = 2048, M = NB * S, FF = 5504, INW = 8752, INP = 8960, NLAYER = 2;
constexpr float EPS = 1e-6f, NEGF = -1e30f;
typedef unsigned short bf16;
typedef short bf16x8 __attribute__((ext_vector_type(8)));
typedef short s16x4 __attribute__((ext_vector_type(4)));
typedef float f32x4 __attribute__((ext_vector_type(4)));
typedef unsigned u32x4 __attribute__((ext_vector_type(4)));
typedef unsigned u32x2 __attribute__((ext_vector_type(2)));
#define LAS __attribute__((address_space(3)))

constexpr size_t AL(size_t x) { return (x + 255) & ~(size_t)255; }
constexpr size_t LW_GU1 = 0;
constexpr size_t LW_D1 = LW_GU1 + AL((size_t)2 * FF * D * 2);
constexpr size_t LW_IN = LW_D1 + AL((size_t)D * FF * 2);
constexpr size_t LW_PN = LW_IN + AL((size_t)INP * D * 2);
constexpr size_t LW_PS = LW_PN + AL((size_t)D * 1024 * 2);
constexpr size_t LW_O = LW_PS + AL((size_t)D * 1024 * 2);
constexpr size_t LW_GU2 = LW_O + AL((size_t)D * D * 2);
constexpr size_t LW_D2 = LW_GU2 + AL((size_t)2 * FF * D * 2);
constexpr size_t LW_C1K = LW_D2 + AL((size_t)D * FF * 2);
constexpr size_t LW_C1V = LW_C1K + AL((size_t)256 * 2048 * 2);
constexpr size_t LW_C2K = LW_C1V + AL((size_t)256 * 2048 * 2);
constexpr size_t LW_C2V = LW_C2K + AL((size_t)64 * 256 * 2);
constexpr size_t LW_SGW = LW_C2V + AL((size_t)64 * 256 * 2);
constexpr size_t LW_B1 = LW_SGW + AL((size_t)8 * 128 * 128 * 2);
constexpr size_t LW_PAR = LW_B1 + AL((size_t)2 * 256 * 4);
constexpr int PAR_QN = 0, PAR_KN = 64, PAR_SGG = 256, PAR_SGB = 1280, PAR_SGBS = 2304, PAR_N1 = 3328, PAR_NM = 5376, PAR_N2 = 7424, PAR_RELB = 9472, PAR_FLOATS = 9984;
constexpr size_t LW_BYTES = LW_PAR + AL((size_t)PAR_FLOATS * 4);
constexpr size_t WS_H = NLAYER * LW_BYTES;
constexpr size_t WS_X = WS_H + AL((size_t)M * D * 2);
constexpr size_t WS_HFF = WS_X;
constexpr size_t KV_ELEMS = (size_t)16 * 2048 * 64;
constexpr size_t WS_Q = WS_X;
constexpr size_t WS_KV = WS_Q + AL((size_t)M * 1024 * 2);
constexpr size_t WS_U = WS_KV + 6 * KV_ELEMS * 2 + 8192;
constexpr size_t WS_V = WS_U + AL((size_t)M * 1024 * 2);
constexpr size_t WS_MG = WS_V + AL((size_t)M * 1024 * 2);
constexpr size_t WS_GATES = WS_MG + AL((size_t)M * 4096 * 2);
constexpr size_t WS_VSTAT = WS_GATES + AL((size_t)M * 48 * 4);
constexpr size_t WS_KCN = WS_VSTAT + AL((size_t)M * 32 * 4);
constexpr size_t WS_VCT = WS_KCN + AL((size_t)16 * 128 * 64 * 2);
constexpr size_t WS_SG = WS_VCT + AL((size_t)16 * 128 * 64 * 2);
constexpr size_t WS_A = WS_SG + AL((size_t)M * 1024 * 2);
constexpr size_t WS_T = WS_A + AL((size_t)M * 1024 * 2);
constexpr size_t WS_MRG = WS_T + AL((size_t)M * D * 2);
constexpr size_t WS_END_A = WS_MRG + AL((size_t)M * D * 2);
constexpr size_t WS_END_B = WS_HFF + AL((size_t)M * FF * 2);
constexpr size_t WS_BAR = WS_END_A > WS_END_B ? WS_END_A : WS_END_B;
constexpr int BARW_TOTAL = 8192, CNT_W0 = 4096;
constexpr size_t WS_SS = WS_BAR + (size_t)BARW_TOTAL * 4;
constexpr size_t WS_L = WS_SS + (size_t)M * 8 * 4;
constexpr size_t WS_SLAB = WS_L + (size_t)M * D * 2;
constexpr size_t WS_END = WS_SLAB;

constexpr int LDS_XCH = 131072;
constexpr int LDS_BYTES = 147456;

struct Args { const float* in[27]; float* out; unsigned char* ws; };

__device__ __forceinline__ LAS unsigned char* lds_base() { extern __shared__ __attribute__((aligned(16))) unsigned char lds_any_[]; return (LAS unsigned char*)lds_any_; }
#define OPQ_S(x) asm volatile("" : "+s"(x))
#define OPQ_V(x) asm volatile("" : "+v"(x))
#define GASP __attribute__((address_space(1)))
#define OPQ_P(x) do { unsigned long long t_ = (unsigned long long)(x); asm volatile("" : "+s"(t_)); x = (decltype(x))(GASP unsigned char*)t_; } while (0)
__device__ __forceinline__ unsigned cvtpk(float lo, float hi) {
    typedef float f2 __attribute__((ext_vector_type(2))); typedef __bf16 b2 __attribute__((ext_vector_type(2)));
    f2 v = {lo, hi}; b2 b = __builtin_convertvector(v, b2); return __builtin_bit_cast(unsigned, b);
}
__device__ __forceinline__ bf16 f2bf(float f) { return (bf16)(cvtpk(f, 0.f) & 0xffffu); }
__device__ __forceinline__ float bflo(unsigned w) { return __builtin_bit_cast(float, w << 16); }
__device__ __forceinline__ float bfhi(unsigned w) { return __builtin_bit_cast(float, w & 0xffff0000u); }
__device__ __forceinline__ float sigm(float x) { return __builtin_amdgcn_rcpf(1.f + __expf(-x)); }
__device__ __forceinline__ float siluf_(float x) { return x * sigm(x); }
__device__ __forceinline__ float gelu_tanh(float x) { return x * sigm(1.5957691216f * (x + 0.044715f * x * x * x)); }
__device__ __forceinline__ float wave_sum(float v) {
#pragma unroll
    for (int o = 1; o < 64; o <<= 1) v += __shfl_xor(v, o);
    return v;
}
__device__ __forceinline__ u32x4 pack8(const float* v) { u32x4 w; w.x = cvtpk(v[0], v[1]); w.y = cvtpk(v[2], v[3]); w.z = cvtpk(v[4], v[5]); w.w = cvtpk(v[6], v[7]); return w; }
__device__ __forceinline__ int t5_bucket(int d) {
    if (d < 16) return d;
    int b = 16;
    b += (d >= 19) + (d >= 21) + (d >= 24) + (d >= 27) + (d >= 31) + (d >= 35) + (d >= 40) + (d >= 46) + (d >= 52) + (d >= 59) + (d >= 67) + (d >= 77) + (d >= 87) + (d >= 99) + (d >= 113);
    return b;
}
constexpr int BIAS_N = 114;

#define EPI_HEAD unsigned char* w_ = ws; OPQ_P(w_); int fr_ = fr, fq_ = fq; OPQ_V(fr_); OPQ_V(fq_);
constexpr int LDS_RSC = 135168, LDS_RSTAG = LDS_RSC + 1024;
#define EPI_RSTD(rs_) float rs_[2][4]; { \
    LAS float* rsc_ = (LAS float*)(lds_base() + LDS_RSC); LAS int* tag_ = (LAS int*)(lds_base() + LDS_RSTAG) + (wr * 4 + wc); \
    if (*tag_ == u.pm + 1) { \
        _Pragma("unroll") for (int ai = 0; ai < 2; ++ai) _Pragma("unroll") for (int m = 0; m < 4; ++m) rs_[ai][m] = rsc_[ai * 128 + wr * 64 + m * 16 + fr_]; \
    } else { \
        const float* ss_ = (const float*)(w_ + WS_SS); \
        _Pragma("unroll") for (int ai = 0; ai < 2; ++ai) _Pragma("unroll") for (int m = 0; m < 4; ++m) { \
            const f32x4 a_ = *(const f32x4*)(ss_ + (size_t)(row0 + ai * 128 + m * 16) * 8), b_ = *(const f32x4*)(ss_ + (size_t)(row0 + ai * 128 + m * 16) * 8 + 4); \
            rs_[ai][m] = rsqrtf((((a_.x + a_.y) + (a_.z + a_.w)) + ((b_.x + b_.y) + (b_.z + b_.w))) * (1.f / D) + EPS); \
            rsc_[ai * 128 + wr * 64 + m * 16 + fr_] = rs_[ai][m]; } \
        *tag_ = u.pm + 1; \
    } }
struct EpiSwiGLU {
    static constexpr bool PERM = true, AFTER_DRAIN = false;
    unsigned char* ws;
    __device__ __forceinline__ void operator()(const pg8::f32x4 (&acc)[2][2][4][2], const pg8::Unit& u, int wr, int wc, int fr, int fq) const {
        EPI_HEAD
        bf16* O = (bf16*)(w_ + WS_HFF);
        const int row0 = u.pm * 256 + wr * 64 + fr_, col0 = u.pn * 128 + wc * 32 + fq_ * 8;
        EPI_RSTD(rs)
#pragma unroll
        for (int ai = 0; ai < 2; ++ai)
#pragma unroll
            for (int m = 0; m < 4; ++m) {
                float v[8]; const float r = rs[ai][m];
#pragma unroll
                for (int n = 0; n < 2; ++n)
#pragma unroll
                    for (int j = 0; j < 4; ++j) v[n * 4 + j] = siluf_(acc[ai][0][m][n][j] * r) * (acc[ai][1][m][n][j] * r);
                *(u32x4*)(O + (size_t)(row0 + ai * 128 + m * 16) * FF + col0) = pack8(v);
            }
    }
};
struct EpiResid {
    static constexpr bool PERM = true, AFTER_DRAIN = false;
    float* OUT; unsigned char* ws; float scale; int last;
    __device__ __forceinline__ void operator()(const pg8::f32x4 (&acc)[2][2][4][2], const pg8::Unit& u, int wr, int wc, int fr, int fq) const {
        float* x_ = OUT; OPQ_P(x_); EPI_HEAD
        bf16* H = (bf16*)(w_ + WS_H); bf16* L = (bf16*)(w_ + WS_L); LAS float* xch = (LAS float*)(lds_base() + LDS_XCH);
        const int row0 = u.pm * 256 + wr * 64 + fr_, col0 = u.pn * 256 + wc * 32 + fq_ * 8;
#pragma unroll
        for (int am = 0; am < 4; ++am) { const int ai = am >> 1, m0 = (am & 1) * 2;
            u32x4 hh[4][2], ll[4][2];
#pragma unroll
            for (int m = m0; m < m0 + 2; ++m)
#pragma unroll
                for (int bj = 0; bj < 2; ++bj) { const size_t off = (size_t)(row0 + ai * 128 + m * 16) * D + col0 + bj * 128; hh[m][bj] = *(const u32x4*)(H + off); ll[m][bj] = *(const u32x4*)(L + off); }
#pragma unroll
            for (int m = m0; m < m0 + 2; ++m) {
                float ss = 0.f;
#pragma unroll
                for (int bj = 0; bj < 2; ++bj) {
                    const size_t off = (size_t)(row0 + ai * 128 + m * 16) * D + col0 + bj * 128;
                    const u32x4 h4 = hh[m][bj], l4 = ll[m][bj];
                    f32x4 a = {bflo(h4.x) + bflo(l4.x), bfhi(h4.x) + bfhi(l4.x), bflo(h4.y) + bflo(l4.y), bfhi(h4.y) + bfhi(l4.y)};
                    f32x4 b = {bflo(h4.z) + bflo(l4.z), bfhi(h4.z) + bfhi(l4.z), bflo(h4.w) + bflo(l4.w), bfhi(h4.w) + bfhi(l4.w)};
                    a += acc[ai][bj][m][0] * scale; b += acc[ai][bj][m][1] * scale;
                    if (last) { *(f32x4*)(x_ + off) = a; *(f32x4*)(x_ + off + 4) = b; }
                    else {
                        u32x4 hb; hb.x = cvtpk(a.x, a.y); hb.y = cvtpk(a.z, a.w); hb.z = cvtpk(b.x, b.y); hb.w = cvtpk(b.z, b.w);
                        u32x4 lb; lb.x = cvtpk(a.x - bflo(hb.x), a.y - bfhi(hb.x)); lb.y = cvtpk(a.z - bflo(hb.y), a.w - bfhi(hb.y)); lb.z = cvtpk(b.x - bflo(hb.z), b.y - bfhi(hb.z)); lb.w = cvtpk(b.z - bflo(hb.w), b.w - bfhi(hb.w));
                        *(u32x4*)(H + off) = hb; *(u32x4*)(L + off) = lb;
                    }
                    ss += (a.x * a.x + a.y * a.y) + (a.z * a.z + a.w * a.w) + (b.x * b.x + b.y * b.y) + (b.z * b.z + b.w * b.w);
                }
                ss += __shfl_xor(ss, 16); ss += __shfl_xor(ss, 32);
                if (fq_ == 0) xch[(ai * 128 + wr * 64 + m * 16 + fr_) * 4 + wc] = ss;
            }
        }
        asm volatile("s_waitcnt lgkmcnt(0)" ::: "memory"); __builtin_amdgcn_s_barrier(); asm volatile("" ::: "memory");
        int tl = threadIdx.x; OPQ_V(tl);
        if (tl < 256) { const f32x4 s4 = *(const LAS f32x4*)(xch + tl * 4); ((float*)(w_ + WS_SS))[(size_t)(u.pm * 256 + tl) * 8 + u.pn] = (s4.x + s4.y) + (s4.z + s4.w); }
    }
};
struct EpiT {
    static constexpr bool PERM = true, AFTER_DRAIN = false;
    unsigned char* ws;
    __device__ __forceinline__ void operator()(const pg8::f32x4 (&acc)[2][2][4][2], const pg8::Unit& u, int wr, int wc, int fr, int fq) const {
        EPI_HEAD
        bf16* T = (bf16*)(w_ + WS_T); const bf16* mg = (const bf16*)(w_ + WS_MG);
        const int row0 = u.pm * 256 + wr * 64 + fr_, col0 = u.pn * 256 + wc * 32 + fq_ * 8;
#pragma unroll
        for (int ai = 0; ai < 2; ++ai) {
            u32x4 gg[4][2];
#pragma unroll
            for (int m = 0; m < 4; ++m)
#pragma unroll
                for (int bj = 0; bj < 2; ++bj) gg[m][bj] = *(const u32x4*)(mg + (size_t)(row0 + ai * 128 + m * 16) * 4096 + 2048 + col0 + bj * 128);
#pragma unroll
            for (int m = 0; m < 4; ++m)
#pragma unroll
                for (int bj = 0; bj < 2; ++bj) {
                    const size_t row = row0 + ai * 128 + m * 16; const int col = col0 + bj * 128;
                    const u32x4 g = gg[m][bj];
                    float v[8];
                    v[0] = bflo(g.x) * acc[ai][bj][m][0][0]; v[1] = bfhi(g.x) * acc[ai][bj][m][0][1]; v[2] = bflo(g.y) * acc[ai][bj][m][0][2]; v[3] = bfhi(g.y) * acc[ai][bj][m][0][3];
                    v[4] = bflo(g.z) * acc[ai][bj][m][1][0]; v[5] = bfhi(g.z) * acc[ai][bj][m][1][1]; v[6] = bflo(g.w) * acc[ai][bj][m][1][2]; v[7] = bfhi(g.w) * acc[ai][bj][m][1][3];
                    *(u32x4*)(T + row * D + col) = pack8(v);
                }
        }
    }
};
struct EpiMerge {
    static constexpr bool PERM = true, AFTER_DRAIN = false;
    unsigned char* ws;
    __device__ __forceinline__ void operator()(const pg8::f32x4 (&acc)[2][2][4][2], const pg8::Unit& u, int wr, int wc, int fr, int fq) const {
        EPI_HEAD
        bf16* O = (bf16*)(w_ + WS_MRG); const bf16* T = (const bf16*)(w_ + WS_T); const bf16* mg = (const bf16*)(w_ + WS_MG);
        const int row0 = u.pm * 256 + wr * 64 + fr_, col0 = u.pn * 256 + wc * 32 + fq_ * 8;
#pragma unroll
        for (int am = 0; am < 4; ++am) { const int ai = am >> 1, m0 = (am & 1) * 2;
            u32x4 gg[4][2], tt[4][2];
#pragma unroll
            for (int m = m0; m < m0 + 2; ++m)
#pragma unroll
                for (int bj = 0; bj < 2; ++bj) { const size_t row = row0 + ai * 128 + m * 16; const int col = col0 + bj * 128; gg[m][bj] = *(const u32x4*)(mg + row * 4096 + col); tt[m][bj] = *(const u32x4*)(T + row * D + col); }
#pragma unroll
            for (int m = m0; m < m0 + 2; ++m)
#pragma unroll
                for (int bj = 0; bj < 2; ++bj) {
                    const size_t row = row0 + ai * 128 + m * 16; const int col = col0 + bj * 128;
                    const u32x4 g = gg[m][bj], t = tt[m][bj];
                    float v[8];
                    v[0] = bflo(g.x) * acc[ai][bj][m][0][0] + bflo(t.x); v[1] = bfhi(g.x) * acc[ai][bj][m][0][1] + bfhi(t.x);
                    v[2] = bflo(g.y) * acc[ai][bj][m][0][2] + bflo(t.y); v[3] = bfhi(g.y) * acc[ai][bj][m][0][3] + bfhi(t.y);
                    v[4] = bflo(g.z) * acc[ai][bj][m][1][0] + bflo(t.z); v[5] = bfhi(g.z) * acc[ai][bj][m][1][1] + bfhi(t.z);
                    v[6] = bflo(g.w) * acc[ai][bj][m][1][2] + bflo(t.w); v[7] = bfhi(g.w) * acc[ai][bj][m][1][3] + bfhi(t.w);
                    *(u32x4*)(O + row * D + col) = pack8(v);
                }
        }
    }
};
struct EpiTM {
    static constexpr bool PERM = true, AFTER_DRAIN = false;
    unsigned char* ws;
    __device__ __forceinline__ void operator()(const pg8::f32x4 (&acc)[2][2][4][2], const pg8::Unit& u, int wr, int wc, int fr, int fq) const {
        if (u.kind == 0) { EpiT t{ws}; t(acc, u, wr, wc, fr, fq); } else { EpiMerge m{ws}; m(acc, u, wr, wc, fr, fq); }
    }
};
struct EpiIn {
    static constexpr bool PERM = true, AFTER_DRAIN = false;
    unsigned char* ws; int l;
    template <int KIND>
    __device__ __forceinline__ void act_tile(const pg8::f32x4 (&acc)[2][2][4][2], const float (&rs)[2][4], unsigned char* w_, int row0, int colt, int statslot, int fq_) const {
        bf16* base = (bf16*)(w_ + (KIND == 0 ? WS_U : (KIND == 1 ? WS_V : WS_MG)));
        constexpr int ldc = KIND == 2 ? 4096 : 1024;
#pragma unroll
        for (int ai = 0; ai < 2; ++ai)
#pragma unroll
            for (int m = 0; m < 4; ++m) {
                const int row = row0 + ai * 128 + m * 16;
                float s1 = 0.f, s2 = 0.f;
#pragma unroll
                for (int bj = 0; bj < 2; ++bj) {
                    float v[8];
#pragma unroll
                    for (int n = 0; n < 2; ++n)
#pragma unroll
                        for (int j = 0; j < 4; ++j) {
                            const float a = acc[ai][bj][m][n][j] * rs[ai][m];
                            const float r = KIND == 2 ? sigm(a) : gelu_tanh(a);
                            v[n * 4 + j] = r;
                            if (KIND == 1) { s1 += r; s2 += r * r; }
                        }
                    *(u32x4*)(base + (size_t)row * ldc + colt + bj * 128) = pack8(v);
                }
                if (KIND == 1) {
                    s1 += __shfl_xor(s1, 16); s1 += __shfl_xor(s1, 32); s2 += __shfl_xor(s2, 16); s2 += __shfl_xor(s2, 32);
                    if (fq_ == 0) { float* sp = (float*)(w_ + WS_VSTAT) + ((size_t)row * 16 + statslot) * 2; sp[0] = s1; sp[1] = s2; }
                }
            }
    }
    __device__ __forceinline__ void operator()(const pg8::f32x4 (&acc)[2][2][4][2], const pg8::Unit& u, int wr, int wc, int fr, int fq) const {
        EPI_HEAD
        const int row0 = u.pm * 256 + wr * 64 + fr_, pn = u.pn;
        EPI_RSTD(rs)
        if (pn < 10) {
            bf16* Q = (bf16*)(w_ + WS_Q); bf16* KV = (bf16*)(w_ + WS_KV);
            const float* par = (const float*)(w_ + (size_t)l * LW_BYTES + LW_PAR);
            const bool isq = pn < 4; const int ten = pn - 4;
            const bool hasn = isq || ten == 2 || ten == 4;
            const float* gn = par + (isq ? PAR_QN : (ten == 2 ? PAR_KN + 64 : PAR_KN + 128));
            const bool tr = (!isq) && (ten == 3 || ten == 5);
            float gv[2][8];
#pragma unroll
            for (int bj = 0; bj < 2; ++bj)
#pragma unroll
                for (int e = 0; e < 8; ++e) gv[bj][e] = hasn ? gn[bj * 32 + fq_ * 8 + e] : 1.f;
#pragma unroll
            for (int ai = 0; ai < 2; ++ai)
#pragma unroll
                for (int m = 0; m < 4; ++m) {
                    const int row = row0 + ai * 128 + m * 16;
                    float ss = 0.f;
#pragma unroll
                    for (int bj = 0; bj < 2; ++bj)
#pragma unroll
                        for (int n = 0; n < 2; ++n)
#pragma unroll
                            for (int j = 0; j < 4; ++j) ss += (acc[ai][bj][m][n][j] * rs[ai][m]) * (acc[ai][bj][m][n][j] * rs[ai][m]);
                    ss += __shfl_xor(ss, 16); ss += __shfl_xor(ss, 32);
                    const float rstd = hasn ? rsqrtf(ss * (1.f / 64.f) + EPS) : 1.f;
                    const int b = row >> 11, s = row & 2047;
#pragma unroll
                    for (int bj = 0; bj < 2; ++bj) {
                        float v[8];
#pragma unroll
                        for (int n = 0; n < 2; ++n)
#pragma unroll
                            for (int j = 0; j < 4; ++j) v[n * 4 + j] = acc[ai][bj][m][n][j] * rs[ai][m] * rstd * gv[bj][n * 4 + j];
                        if (isq) *(u32x4*)(Q + (size_t)row * 1024 + (pn * 4 + wc) * 64 + bj * 32 + fq_ * 8) = pack8(v);
                        else if (!tr) *(u32x4*)(KV + (size_t)ten * KV_ELEMS + ((size_t)(b * 4 + wc) * 2048 + s) * 64 + bj * 32 + fq_ * 8) = pack8(v);
                        else {
                            bf16* p = KV + (size_t)ten * KV_ELEMS + ((size_t)(b * 4 + wc) * 64 + bj * 32 + fq_ * 8) * 2048 + s;
#pragma unroll
                            for (int e = 0; e < 8; ++e) p[(size_t)e * 2048] = f2bf(v[e]);
                        }
                    }
                }
        } else if (pn < 34) {
            if (pn < 14) act_tile<0>(acc, rs, w_, row0, (pn - 10) * 256 + wc * 32 + fq_ * 8, 0, fq_);
            else if (pn < 18) act_tile<1>(acc, rs, w_, row0, (pn - 14) * 256 + wc * 32 + fq_ * 8, (pn - 14) * 4 + wc, fq_);
            else act_tile<2>(acc, rs, w_, row0, (pn - 18) * 256 + wc * 32 + fq_ * 8, 0, fq_);
        } else {
            float* GATES = (float*)(w_ + WS_GATES);
#pragma unroll
            for (int ai = 0; ai < 2; ++ai)
#pragma unroll
                for (int m = 0; m < 4; ++m) {
                    const int row = row0 + ai * 128 + m * 16;
#pragma unroll
                    for (int n = 0; n < 2; ++n)
#pragma unroll
                        for (int j = 0; j < 4; ++j) { const int col = wc * 32 + fq_ * 8 + n * 4 + j; if (col < 48) GATES[(size_t)row * 48 + col] = sigm(acc[ai][0][m][n][j] * rs[ai][m]); }
                }
        }
    }
};

__device__ __forceinline__ void p0_item(const float* s0, const float* s1, int nv0, int nv1, int N, bf16* dst, int K, LAS float* scr, int lane, const float* gain  ) {
    const int r = lane >> 4, c4 = lane & 15, hf = c4 >> 3, cc = (c4 & 7) * 4;
    const float* src = (hf ? s1 : s0) + (size_t)r * N + cc;
    const bool ok = cc < (hf ? nv1 : nv0);
    f32x4 v[16];
#pragma unroll
    for (int i = 0; i < 16; ++i) v[i] = ok ? __builtin_nontemporal_load((const f32x4*)(src + (size_t)(4 * i) * N)) : (f32x4){0.f, 0.f, 0.f, 0.f};
#pragma unroll
    for (int i = 0; i < 16; ++i) { const float gk = gain ? gain[4 * i + r] : 1.f; LAS float* d = scr + (4 * i + r) * 65 + 4 * c4; d[0] = v[i].x * gk; d[1] = v[i].y * gk; d[2] = v[i].z * gk; d[3] = v[i].w * gk; }
    const int c = lane & 7;
#pragma unroll
    for (int j = 0; j < 8; ++j) {
        const int n = (lane >> 3) + 8 * j; const LAS float* s = scr + (8 * c) * 65 + n;
        u32x4 o; o.x = cvtpk(s[0 * 65], s[1 * 65]); o.y = cvtpk(s[2 * 65], s[3 * 65]); o.z = cvtpk(s[4 * 65], s[5 * 65]); o.w = cvtpk(s[6 * 65], s[7 * 65]);
        __builtin_nontemporal_store(o, (u32x4*)(dst + (size_t)n * K + 8 * c));
    }
}
__device__ __forceinline__ int win_src_col(int n0, int& nvalid) {
    const int tile = n0 >> 8, r = n0 & 255, bj = r >> 7, wc = (r & 127) >> 5;
    nvalid = 32;
    if (tile < 4) return (tile * 4 + wc) * 64 + bj * 32;
    if (tile < 10) return 1024 + (tile - 4) * 256 + wc * 64 + bj * 32;
    if (tile < 18) return 2608 + (tile - 10) * 256 + r;
    if (tile < 34) return 4656 + (tile - 18) * 256 + r;
    nvalid = r < 48 ? (48 - r < 32 ? 48 - r : 32) : 0;
    return r < 48 ? 2560 + r : 0;
}
__device__ __forceinline__ void p0_matrix(int type  , const float* W0, const float* W1, int K, int Nsrc, int Ndst, bf16* dst, LAS float* scr, int gw, int NGW, int lane, const float* gain) {
    const int nruns = Ndst >> 6, nitems = (K >> 6) * nruns;
    for (int it = gw; it < nitems; it += NGW) {
        const int kb = it / nruns, nb = it - kb * nruns, n0 = nb * 64, k0 = kb * 64;
        const float* src = W0; int c0 = n0, c1 = n0 + 32, nv0 = 32, nv1 = 32;
        if (type == 1) { const int tile = n0 >> 8, r = n0 & 255; src = r < 128 ? W0 : W1; c0 = tile * 128 + (r & 127); c1 = c0 + 32; }
        else if (type == 2) { c0 = win_src_col(n0, nv0); c1 = win_src_col(n0 + 32, nv1); }
        const float* rowp = src + (size_t)k0 * Nsrc;
        p0_item(rowp + c0, rowp + c1, nv0, nv1, Nsrc, dst + (size_t)n0 * K + k0, K, scr, lane, gain ? gain + k0 : nullptr);
    }
}
constexpr unsigned CV_GU1 = 1u, CV_D1 = 2u, CV_WIN = 4u, CV_PN = 8u, CV_PS = 16u, CV_O = 32u, CV_GU2 = 64u, CV_D2 = 128u, CV_C1K = 256u, CV_C1V = 512u, CV_C2K = 1024u, CV_C2V = 2048u;
constexpr unsigned CV_SMALL = CV_PN | CV_PS | CV_O | CV_C1K | CV_C1V | CV_C2K | CV_C2V;
struct CvPtrs { const float* in[27]; };
#define CV_ARGS(a_) CvPtrs{{nullptr, nullptr, a_.in[2], a_.in[3], a_.in[4], a_.in[5], a_.in[6], a_.in[7], nullptr, nullptr, nullptr, nullptr, a_.in[12], a_.in[13], a_.in[14], a_.in[15], nullptr, nullptr, nullptr, nullptr, a_.in[20], a_.in[21], a_.in[22], a_.in[23], a_.in[24], a_.in[25], a_.in[26]}}
__device__ __forceinline__ void conv_set(const CvPtrs args, unsigned char* ws, int l, unsigned mask, LAS float* scr, int gw, int NGW, int lane) {
    unsigned char* lw = ws + (size_t)l * LW_BYTES;
    if (mask & CV_GU1) p0_matrix(1, args.in[3] + (size_t)l * D * FF, args.in[4] + (size_t)l * D * FF, D, FF, 2 * FF, (bf16*)(lw + LW_GU1), scr, gw, NGW, lane, args.in[2] + (size_t)l * D);
    if (mask & CV_D1) p0_matrix(0, args.in[5] + (size_t)l * FF * D, nullptr, FF, D, D, (bf16*)(lw + LW_D1), scr, gw, NGW, lane, nullptr);
    if (mask & CV_WIN) p0_matrix(2, args.in[7] + (size_t)l * D * INW, nullptr, D, INW, INP, (bf16*)(lw + LW_IN), scr, gw, NGW, lane, args.in[6] + (size_t)l * D);
    if (mask & CV_PN) p0_matrix(0, args.in[20] + (size_t)l * 1024 * D, nullptr, 1024, D, D, (bf16*)(lw + LW_PN), scr, gw, NGW, lane, nullptr);
    if (mask & CV_PS) p0_matrix(0, args.in[21] + (size_t)l * 1024 * D, nullptr, 1024, D, D, (bf16*)(lw + LW_PS), scr, gw, NGW, lane, nullptr);
    if (mask & CV_O) p0_matrix(0, args.in[22] + (size_t)l * D * D, nullptr, D, D, D, (bf16*)(lw + LW_O), scr, gw, NGW, lane, nullptr);
    if (mask & CV_GU2) p0_matrix(1, args.in[24] + (size_t)l * D * FF, args.in[25] + (size_t)l * D * FF, D, FF, 2 * FF, (bf16*)(lw + LW_GU2), scr, gw, NGW, lane, args.in[23] + (size_t)l * D);
    if (mask & CV_D2) p0_matrix(0, args.in[26] + (size_t)l * FF * D, nullptr, FF, D, D, (bf16*)(lw + LW_D2), scr, gw, NGW, lane, nullptr);
    if (mask & CV_C1K) p0_matrix(0, args.in[12] + (size_t)l * 2048 * 256, nullptr, 2048, 256, 256, (bf16*)(lw + LW_C1K), scr, gw, NGW, lane, nullptr);
    if (mask & CV_C1V) p0_matrix(0, args.in[14] + (size_t)l * 2048 * 256, nullptr, 2048, 256, 256, (bf16*)(lw + LW_C1V), scr, gw, NGW, lane, nullptr);
    if (mask & CV_C2K) p0_matrix(0, args.in[13] + (size_t)l * 256 * 64, nullptr, 256, 64, 64, (bf16*)(lw + LW_C2K), scr, gw, NGW, lane, nullptr);
    if (mask & CV_C2V) p0_matrix(0, args.in[15] + (size_t)l * 256 * 64, nullptr, 256, 64, 64, (bf16*)(lw + LW_C2V), scr, gw, NGW, lane, nullptr);
}
__device__ __forceinline__ void prep_row(const float* xrow, bf16* hrow, bf16* lrow, float* ssrow, int lane) {
    float ss = 0.f;
#pragma unroll
    for (int j = 0; j < 8; ++j) {
        const f32x4 v = *(const f32x4*)(xrow + 4 * lane + 256 * j);
        ss += (v.x * v.x + v.y * v.y) + (v.z * v.z + v.w * v.w);
        u32x2 o; o.x = cvtpk(v.x, v.y); o.y = cvtpk(v.z, v.w);
        u32x2 lo; lo.x = cvtpk(v.x - bflo(o.x), v.y - bfhi(o.x)); lo.y = cvtpk(v.z - bflo(o.y), v.w - bfhi(o.y));
        *(u32x2*)(hrow + 4 * lane + 256 * j) = o; *(u32x2*)(lrow + 4 * lane + 256 * j) = lo;
    }
    ss = wave_sum(ss);
    if (lane < 8) ssrow[lane] = lane == 0 ? ss : 0.f;
}

__device__ __forceinline__ void compress_unit(int cu, const bf16* KVB, const bf16* w1k, const bf16* w1v, const bf16* w2k, const bf16* w2v, const float* bias1, const float* kn0,
                                              bf16* KCN, bf16* VCT, unsigned char* lds) {
    int tid_ = threadIdx.x; OPQ_V(tid_); const int tid = tid_, lane = tid & 63, w = __builtin_amdgcn_readfirstlane(tid >> 6), qi = lane & 15, q4 = lane >> 4;
    const int isv = cu >> 7, bg = (cu >> 3) & 15, r = cu & 7;
    const bf16* src = KVB + (size_t)isv * KV_ELEMS + (size_t)bg * 2048 * 64;
    const bf16* w1 = isv ? w1v : w1k; const bf16* w2 = isv ? w2v : w2k;
    const bf16* arow = src + (size_t)(16 * (16 * r + qi)) * 64 + q4 * 8;
    const bf16* b0p = w1 + (size_t)(32 * w + qi) * 2048 + q4 * 8;
    const bf16* b1p = b0p + (size_t)16 * 2048;
    f32x4 h0 = {0.f, 0.f, 0.f, 0.f}, h1 = {0.f, 0.f, 0.f, 0.f};
    bf16x8 fa[2][8], fb0[2][8], fb1[2][8];
#define CU_LOAD(set_, bt_) do { _Pragma("unroll") for (int i_ = 0; i_ < 8; ++i_) { const int ko_ = ((bt_) * 8 + i_) * 32; fa[set_][i_] = *(const bf16x8*)(arow + ko_); fb0[set_][i_] = *(const bf16x8*)(b0p + ko_); fb1[set_][i_] = *(const bf16x8*)(b1p + ko_); } } while (0)
#define CU_MMA(set_) do { _Pragma("unroll") for (int i_ = 0; i_ < 8; ++i_) { h0 = __builtin_amdgcn_mfma_f32_16x16x32_bf16(fa[set_][i_], fb0[set_][i_], h0, 0, 0, 0); h1 = __builtin_amdgcn_mfma_f32_16x16x32_bf16(fa[set_][i_], fb1[set_][i_], h1, 0, 0, 0); } } while (0)
    CU_LOAD(0, 0);
#pragma unroll 1
    for (int bt = 0; bt < 8; bt += 2) {
        CU_LOAD(1, bt + 1);
        CU_MMA(0);
        if (bt + 2 < 8) CU_LOAD(0, bt + 2);
        CU_MMA(1);
    }
#undef CU_LOAD
#undef CU_MMA
    bf16* hid = (bf16*)lds;
    const float bb0 = bias1[isv * 256 + 32 * w + qi], bb1 = bias1[isv * 256 + 32 * w + 16 + qi];
#pragma unroll
    for (int j = 0; j < 4; ++j) { hid[(4 * q4 + j) * 264 + 32 * w + qi] = f2bf(siluf_(h0[j] + bb0)); hid[(4 * q4 + j) * 264 + 32 * w + 16 + qi] = f2bf(siluf_(h1[j] + bb1)); }
    __syncthreads();
    if (w == 0) {
        f32x4 o[4];
#pragma unroll
        for (int et = 0; et < 4; ++et) o[et] = (f32x4){0.f, 0.f, 0.f, 0.f};
        bf16x8 wb[8][4];
#pragma unroll
        for (int k2 = 0; k2 < 8; ++k2)
#pragma unroll
            for (int et = 0; et < 4; ++et) wb[k2][et] = *(const bf16x8*)(w2 + (size_t)(et * 16 + qi) * 256 + k2 * 32 + q4 * 8);
        asm volatile("" ::: "memory");
#pragma unroll
        for (int k2 = 0; k2 < 8; ++k2) {
            const bf16x8 a = *(const bf16x8*)(hid + qi * 264 + k2 * 32 + q4 * 8);
#pragma unroll
            for (int et = 0; et < 4; ++et) o[et] = __builtin_amdgcn_mfma_f32_16x16x32_bf16(a, wb[k2][et], o[et], 0, 0, 0);
        }
        if (!isv) {
#pragma unroll
            for (int j = 0; j < 4; ++j) {
                float ss = o[0][j] * o[0][j] + o[1][j] * o[1][j] + o[2][j] * o[2][j] + o[3][j] * o[3][j];
                ss += __shfl_xor(ss, 1); ss += __shfl_xor(ss, 2); ss += __shfl_xor(ss, 4); ss += __shfl_xor(ss, 8);
                const float rstd = rsqrtf(ss * (1.f / 64.f) + EPS);
                const int c = 16 * r + 4 * q4 + j;
#pragma unroll
                for (int et = 0; et < 4; ++et) KCN[((size_t)bg * 128 + c) * 64 + et * 16 + qi] = (c < 127) ? f2bf(o[et][j] * rstd * kn0[et * 16 + qi]) : (bf16)0;
            }
        } else {
            const int c0 = 16 * r + 4 * q4;
#pragma unroll
            for (int et = 0; et < 4; ++et) {
                u32x2 pk; pk.x = cvtpk(o[et][0], o[et][1]); pk.y = cvtpk(o[et][2], (c0 + 3 < 127) ? o[et][3] : 0.f);
                *(u32x2*)(VCT + ((size_t)bg * 64 + et * 16 + qi) * 128 + c0) = pk;
            }
        }
    }
    __syncthreads();
}

__device__ __forceinline__ void sgu_unit(int su, const bf16* U, const bf16* V, const float* VSTAT, const float* lng, const float* lnb, const bf16* WS  , const float* bs  ,
                                         bf16* SG, unsigned char* lds) {
    int tid_ = threadIdx.x; OPQ_V(tid_); const int tid = tid_, lane = tid & 63, w = __builtin_amdgcn_readfirstlane(tid >> 6), qi = lane & 15, q4 = lane >> 4;
    const int cc = su >> 3, g = su & 7, r0 = cc * 128;
    float* mu = (float*)lds; float* rs = mu + 128; bf16* vnT = (bf16*)(lds + 1024);
    const int tt = w, nks = (16 * tt + 15) / 32 + 1, t = tt * 16 + qi;
    u32x4 vraw[4];
#pragma unroll
    for (int i = 0; i < 4; ++i) { const int id = tid + 512 * i, s = id >> 4, dc = id & 15; vraw[i] = *(const u32x4*)(V + (size_t)(r0 + s) * 1024 + g * 128 + dc * 8); }
    bf16x8 bw[4];
    const bf16* wp = WS + ((size_t)g * 128 + tt * 16 + qi) * 128 + q4 * 8;
#pragma unroll
    for (int ks = 0; ks < 4; ++ks) bw[ks] = (ks < nks) ? *(const bf16x8*)(wp + ks * 32) : (bf16x8){0, 0, 0, 0, 0, 0, 0, 0};
    u32x2 uu[8];
#pragma unroll
    for (int dt = 0; dt < 8; ++dt) uu[dt] = *(const u32x2*)(U + (size_t)(r0 + t) * 1024 + g * 128 + dt * 16 + q4 * 4);
    const float bias = bs[g * 128 + t];
    if (tid < 128) {
        const float* sp = VSTAT + (size_t)(r0 + tid) * 32; float s1 = 0.f, s2 = 0.f;
#pragma unroll
        for (int i = 0; i < 8; ++i) { const f32x4 q = *(const f32x4*)(sp + 4 * i); s1 += q.x + q.z; s2 += q.y + q.w; }
        const float mean = s1 * (1.f / 1024.f); float var = s2 * (1.f / 1024.f) - mean * mean; var = var > 0.f ? var : 0.f;
        mu[tid] = mean; rs[tid] = rsqrtf(var + EPS);
    }
    __syncthreads();
#pragma unroll
    for (int i = 0; i < 4; ++i) {
        const int id = tid + 512 * i, s = id >> 4, dc = id & 15;
        const u32x4 raw = vraw[i];
        const float m_ = mu[s], r_ = rs[s];
        const f32x4 g0 = *(const f32x4*)(lng + g * 128 + dc * 8), g1 = *(const f32x4*)(lng + g * 128 + dc * 8 + 4), b0 = *(const f32x4*)(lnb + g * 128 + dc * 8), b1 = *(const f32x4*)(lnb + g * 128 + dc * 8 + 4);
        const float gp[8] = {g0.x, g0.y, g0.z, g0.w, g1.x, g1.y, g1.z, g1.w}, bp[8] = {b0.x, b0.y, b0.z, b0.w, b1.x, b1.y, b1.z, b1.w};
        float v[8] = {bflo(raw.x), bfhi(raw.x), bflo(raw.y), bfhi(raw.y), bflo(raw.z), bfhi(raw.z), bflo(raw.w), bfhi(raw.w)};
#pragma unroll
        for (int e = 0; e < 8; ++e) vnT[(dc * 8 + e) * 136 + s] = f2bf((v[e] - m_) * r_ * gp[e] + bp[e]);
    }
    __syncthreads();
    f32x4 acc[8];
#pragma unroll
    for (int dt = 0; dt < 8; ++dt) acc[dt] = (f32x4){0.f, 0.f, 0.f, 0.f};
#pragma unroll
    for (int ks = 0; ks < 4; ++ks) if (ks < nks) {
#pragma unroll
        for (int dt = 0; dt < 8; ++dt) { const bf16x8 av = *(const bf16x8*)(vnT + (dt * 16 + qi) * 136 + ks * 32 + q4 * 8); acc[dt] = __builtin_amdgcn_mfma_f32_16x16x32_bf16(av, bw[ks], acc[dt], 0, 0, 0); }
    }
#pragma unroll
    for (int dt = 0; dt < 8; ++dt) {
        const size_t off = (size_t)(r0 + t) * 1024 + g * 128 + dt * 16 + q4 * 4;
        u32x2 o; o.x = cvtpk(bflo(uu[dt].x) * (acc[dt][0] + bias), bfhi(uu[dt].x) * (acc[dt][1] + bias)); o.y = cvtpk(bflo(uu[dt].y) * (acc[dt][2] + bias), bfhi(uu[dt].y) * (acc[dt][3] + bias));
        *(u32x2*)(SG + off) = o;
    }
    __syncthreads();
}

__device__ __forceinline__ void half_bar(LAS unsigned* ctr, unsigned& target) {
    target += 4u;
    asm volatile("s_waitcnt lgkmcnt(0)" ::: "memory");
    if ((threadIdx.x & 63) == 0) (void)__hip_atomic_fetch_add(ctr, 1u, __ATOMIC_RELAXED, __HIP_MEMORY_SCOPE_WORKGROUP);
    while (__hip_atomic_load(ctr, __ATOMIC_RELAXED, __HIP_MEMORY_SCOPE_WORKGROUP) < target) __builtin_amdgcn_s_sleep(1);
    asm volatile("" ::: "memory");
}
constexpr int CSP_HID = 0, CSP_CTR = 8448, CSP_SGU = 9216;
__device__ __forceinline__ void cs_pair(int cu, int su0, int su1, const bf16* KVB, const bf16* w1k, const bf16* w1v, const bf16* w2k, const bf16* w2v, const float* bias1, const float* kn0, bf16* KCN, bf16* VCT,
                                        const bf16* U, const bf16* V, const float* VSTAT, const float* lng, const float* lnb, const bf16* WS, const float* bs, bf16* SG, unsigned char* lds) {
    int tid_ = threadIdx.x; OPQ_V(tid_); const int tid = tid_, lane = tid & 63, w = __builtin_amdgcn_readfirstlane(tid >> 6), qi = lane & 15, q4 = lane >> 4;
    LAS unsigned* ctr = (LAS unsigned*)(lds_base() + CSP_CTR);
    if (tid < 2) ctr[tid] = 0u;
    __syncthreads();
    unsigned target = 0u;
    if (w < 4) {
        const int isv = cu >> 7, bg = (cu >> 3) & 15, r = cu & 7;
        const bf16* src = KVB + (size_t)isv * KV_ELEMS + (size_t)bg * 2048 * 64;
        const bf16* w1 = isv ? w1v : w1k; const bf16* w2 = isv ? w2v : w2k;
        const bf16* arow = src + (size_t)(16 * (16 * r + qi)) * 64 + q4 * 8;
        const bf16* bp = w1 + (size_t)(64 * w + qi) * 2048 + q4 * 8;
        f32x4 h[4];
#pragma unroll
        for (int nt = 0; nt < 4; ++nt) h[nt] = (f32x4){0.f, 0.f, 0.f, 0.f};
        bf16x8 fa[2][4], fb[2][4][4];
#define CP_LOAD(set_, bt_) do { _Pragma("unroll") for (int i_ = 0; i_ < 4; ++i_) { const int ko_ = ((bt_) * 4 + i_) * 32; fa[set_][i_] = *(const bf16x8*)(arow + ko_); \
            _Pragma("unroll") for (int nt = 0; nt < 4; ++nt) fb[set_][i_][nt] = *(const bf16x8*)(bp + (size_t)nt * 16 * 2048 + ko_); } } while (0)
#define CP_MMA(set_) do { _Pragma("unroll") for (int i_ = 0; i_ < 4; ++i_) _Pragma("unroll") for (int nt = 0; nt < 4; ++nt) h[nt] = __builtin_amdgcn_mfma_f32_16x16x32_bf16(fa[set_][i_], fb[set_][i_][nt], h[nt], 0, 0, 0); } while (0)
        CP_LOAD(0, 0);
#pragma unroll 1
        for (int bt = 0; bt < 16; bt += 2) {
            CP_LOAD(1, bt + 1);
            CP_MMA(0);
            if (bt + 2 < 16) CP_LOAD(0, bt + 2);
            CP_MMA(1);
        }
#undef CP_LOAD
#undef CP_MMA
        bf16* hid = (bf16*)(lds + CSP_HID);
#pragma unroll
        for (int nt = 0; nt < 4; ++nt) {
            const int col = 64 * w + 16 * nt + qi; const float bb = bias1[isv * 256 + col];
#pragma unroll
            for (int j = 0; j < 4; ++j) hid[(4 * q4 + j) * 264 + col] = f2bf(siluf_(h[nt][j] + bb));
        }
        half_bar(ctr, target);
        if (w == 0) {
            f32x4 o[4];
#pragma unroll
            for (int et = 0; et < 4; ++et) o[et] = (f32x4){0.f, 0.f, 0.f, 0.f};
            bf16x8 wb[8][4];
#pragma unroll
            for (int k2 = 0; k2 < 8; ++k2)
#pragma unroll
                for (int et = 0; et < 4; ++et) wb[k2][et] = *(const bf16x8*)(w2 + (size_t)(et * 16 + qi) * 256 + k2 * 32 + q4 * 8);
#pragma unroll
            for (int k2 = 0; k2 < 8; ++k2) {
                const bf16x8 a = *(const bf16x8*)(hid + qi * 264 + k2 * 32 + q4 * 8);
#pragma unroll
                for (int et = 0; et < 4; ++et) o[et] = __builtin_amdgcn_mfma_f32_16x16x32_bf16(a, wb[k2][et], o[et], 0, 0, 0);
            }
            if (!isv) {
#pragma unroll
                for (int j = 0; j < 4; ++j) {
                    float ss = o[0][j] * o[0][j] + o[1][j] * o[1][j] + o[2][j] * o[2][j] + o[3][j] * o[3][j];
                    ss += __shfl_xor(ss, 1); ss += __shfl_xor(ss, 2); ss += __shfl_xor(ss, 4); ss += __shfl_xor(ss, 8);
                    const float rstd = rsqrtf(ss * (1.f / 64.f) + EPS);
                    const int c = 16 * r + 4 * q4 + j;
#pragma unroll
                    for (int et = 0; et < 4; ++et) KCN[((size_t)bg * 128 + c) * 64 + et * 16 + qi] = (c < 127) ? f2bf(o[et][j] * rstd * kn0[et * 16 + qi]) : (bf16)0;
                }
            } else {
                const int c0 = 16 * r + 4 * q4;
#pragma unroll
                for (int et = 0; et < 4; ++et) {
                    u32x2 pk; pk.x = cvtpk(o[et][0], o[et][1]); pk.y = cvtpk(o[et][2], (c0 + 3 < 127) ? o[et][3] : 0.f);
                    *(u32x2*)(VCT + ((size_t)bg * 64 + et * 16 + qi) * 128 + c0) = pk;
                }
            }
        }
    } else {
        LAS unsigned* ctr2 = ctr + 1;
        const int wl = w - 4, t4 = tid - 256;
        float* mu = (float*)(lds + CSP_SGU); float* rs = mu + 128; bf16* vnT = (bf16*)(lds + CSP_SGU + 1024);
#pragma unroll 1
        for (int uu = 0; uu < 2; ++uu) {
            const int su = uu ? su1 : su0, cc = su >> 3, g = su & 7, r0 = cc * 128;
            u32x4 vraw[8];
#pragma unroll
            for (int i = 0; i < 8; ++i) { const int id = t4 + 256 * i, s = id >> 4, dc = id & 15; vraw[i] = *(const u32x4*)(V + (size_t)(r0 + s) * 1024 + g * 128 + dc * 8); }
            if (t4 < 128) {
                const float* sp = VSTAT + (size_t)(r0 + t4) * 32; float s1 = 0.f, s2 = 0.f;
#pragma unroll
                for (int i = 0; i < 8; ++i) { const f32x4 q = *(const f32x4*)(sp + 4 * i); s1 += q.x + q.z; s2 += q.y + q.w; }
                const float mean = s1 * (1.f / 1024.f); float var = s2 * (1.f / 1024.f) - mean * mean; var = var > 0.f ? var : 0.f;
                mu[t4] = mean; rs[t4] = rsqrtf(var + EPS);
            }
            half_bar(ctr2, target);
#pragma unroll
            for (int i = 0; i < 8; ++i) {
                const int id = t4 + 256 * i, s = id >> 4, dc = id & 15;
                const u32x4 raw = vraw[i];
                const float m_ = mu[s], r_ = rs[s];
                const f32x4 g0 = *(const f32x4*)(lng + g * 128 + dc * 8), g1 = *(const f32x4*)(lng + g * 128 + dc * 8 + 4), b0 = *(const f32x4*)(lnb + g * 128 + dc * 8), b1 = *(const f32x4*)(lnb + g * 128 + dc * 8 + 4);
                const float gp[8] = {g0.x, g0.y, g0.z, g0.w, g1.x, g1.y, g1.z, g1.w}, bp[8] = {b0.x, b0.y, b0.z, b0.w, b1.x, b1.y, b1.z, b1.w};
                float v[8] = {bflo(raw.x), bfhi(raw.x), bflo(raw.y), bfhi(raw.y), bflo(raw.z), bfhi(raw.z), bflo(raw.w), bfhi(raw.w)};
#pragma unroll
                for (int e = 0; e < 8; ++e) vnT[(dc * 8 + e) * 136 + ((((s >> 3) ^ dc) << 3) | (s & 7))] = f2bf((v[e] - m_) * r_ * gp[e] + bp[e]);
            }
            half_bar(ctr2, target);
#pragma unroll
            for (int th = 0; th < 2; ++th) {
                const int tt = 2 * wl + th, nks = (16 * tt + 15) / 32 + 1, t = tt * 16 + qi;
                const bf16* wp = WS + ((size_t)g * 128 + t) * 128 + q4 * 8;
                bf16x8 bw[4];
#pragma unroll
                for (int ks = 0; ks < 4; ++ks) bw[ks] = (ks < nks) ? *(const bf16x8*)(wp + ks * 32) : (bf16x8){0, 0, 0, 0, 0, 0, 0, 0};
                u32x2 uv[8];
#pragma unroll
                for (int dt = 0; dt < 8; ++dt) uv[dt] = *(const u32x2*)(U + (size_t)(r0 + t) * 1024 + g * 128 + dt * 16 + q4 * 4);
                const float bias = bs[g * 128 + t];
                f32x4 acc[8];
#pragma unroll
                for (int dt = 0; dt < 8; ++dt) acc[dt] = (f32x4){0.f, 0.f, 0.f, 0.f};
#pragma unroll
                for (int ks = 0; ks < 4; ++ks) if (ks < nks) {
#pragma unroll
                    for (int dt = 0; dt < 8; ++dt) { const bf16x8 av = *(const bf16x8*)(vnT + (dt * 16 + qi) * 136 + (((ks * 4 + q4) ^ (dt * 2 + (qi >> 3))) << 3)); acc[dt] = __builtin_amdgcn_mfma_f32_16x16x32_bf16(av, bw[ks], acc[dt], 0, 0, 0); }
                }
#pragma unroll
                for (int dt = 0; dt < 8; ++dt) {
                    const size_t off = (size_t)(r0 + t) * 1024 + g * 128 + dt * 16 + q4 * 4;
                    u32x2 o; o.x = cvtpk(bflo(uv[dt].x) * (acc[dt][0] + bias), bfhi(uv[dt].x) * (acc[dt][1] + bias)); o.y = cvtpk(bflo(uv[dt].y) * (acc[dt][2] + bias), bfhi(uv[dt].y) * (acc[dt][3] + bias));
                    *(u32x2*)(SG + off) = o;
                }
            }
            half_bar(ctr2, target);
        }
    }
    __syncthreads();
}

__device__ __forceinline__ bf16x8 pack_p(const float* a, const float* b) { u32x4 w; w.x = cvtpk(a[0], a[1]); w.y = cvtpk(a[2], a[3]); w.z = cvtpk(b[0], b[1]); w.w = cvtpk(b[2], b[3]); return __builtin_bit_cast(bf16x8, w); }
__device__ __forceinline__ bf16x8 ldv(const bf16* p) { const s16x4 lo = *(const s16x4*)p, hi = *(const s16x4*)(p + 16); return __builtin_shufflevector(lo, hi, 0, 1, 2, 3, 4, 5, 6, 7); }

constexpr float LOG2E = 1.4426950408889634f, SC2 = 0.125f * LOG2E;
constexpr int AL_KV0 = 40960, KV_STAGE = 18432, AKP = 144;
#define LBAR() do { asm volatile("s_waitcnt lgkmcnt(0)" ::: "memory"); __builtin_amdgcn_s_barrier(); asm volatile("" ::: "memory"); } while (0)
constexpr float MASKV = -3.0e38f;
typedef float f32x2 __attribute__((ext_vector_type(2)));
template <int MODE>
__device__ __forceinline__ void attn_step(const unsigned char* sb, int st, const bf16x8 qf0, const bf16x8 qf1, int t, int p0, bool sel, const float* bias, float cfar, f32x4 (&o)[4], float& mrun, float& lrun,
                                          int koff, int voff, int q4) {
    const int key0 = st * 64;
    f32x4 s[4];
#pragma unroll
    for (int kt = 0; kt < 4; ++kt) {
        const bf16x8 k0 = *(const bf16x8*)(sb + koff + kt * 16 * AKP), k1 = *(const bf16x8*)(sb + koff + kt * 16 * AKP + 64);
        s[kt] = (f32x4){0.f, 0.f, 0.f, 0.f};
        s[kt] = __builtin_amdgcn_mfma_f32_16x16x32_bf16(k0, qf0, s[kt], 0, 0, 0); s[kt] = __builtin_amdgcn_mfma_f32_16x16x32_bf16(k1, qf1, s[kt], 0, 0, 0);
    }
    const bool far = (p0 - (key0 + 63) >= BIAS_N - 1) && (MODE == 0 || (p0 + 15 - key0 < 512));
    bf16x8 vfr[4][2];
#pragma unroll
    for (int dt = 0; dt < 4; ++dt) { vfr[dt][0] = *(const bf16x8*)(sb + voff + dt * 16 * AKP); vfr[dt][1] = *(const bf16x8*)(sb + voff + dt * 16 * AKP + 64); }
    float fsc = 1.f, fc = 0.f;
    if (far) {
        fc = (MODE == 0 && !sel) ? MASKV : cfar; fsc = (MODE == 0 && !sel) ? 0.f : SC2;
    } else {
#pragma unroll
        for (int kt = 0; kt < 4; ++kt)
#pragma unroll
            for (int j = 0; j < 4; ++j) {
                const int dist = t - (key0 + kt * 16 + q4 * 4 + j);
                const bool v = (dist >= 0) && (MODE == 0 ? sel : (dist < 512));
                const int bi = dist < 0 ? 0 : (dist > BIAS_N - 1 ? BIAS_N - 1 : dist);
                const float l = s[kt][j] * SC2 + bias[bi];
                s[kt][j] = v ? l : MASKV;
            }
    }
    float mx = fmaxf(fmaxf(fmaxf(s[0][0], s[0][1]), fmaxf(s[0][2], s[0][3])), fmaxf(fmaxf(s[1][0], s[1][1]), fmaxf(s[1][2], s[1][3])));
    mx = fmaxf(mx, fmaxf(fmaxf(fmaxf(s[2][0], s[2][1]), fmaxf(s[2][2], s[2][3])), fmaxf(fmaxf(s[3][0], s[3][1]), fmaxf(s[3][2], s[3][3]))));
    mx = mx * fsc + fc;
    mx = fmaxf(mx, __shfl_xor(mx, 16)); mx = fmaxf(mx, __shfl_xor(mx, 32));
    const float mnew = fmaxf(mrun, mx);
    f32x4 ps4 = {0.f, 0.f, 0.f, 0.f};
    const float foff = fc - mnew;
#pragma unroll
    for (int kt = 0; kt < 4; ++kt) {
        s[kt] = s[kt] * fsc + foff;
#pragma unroll
        for (int j = 0; j < 4; ++j) s[kt][j] = __builtin_amdgcn_exp2f(s[kt][j]);
        ps4 += s[kt];
    }
    const float ps = (ps4.x + ps4.y) + (ps4.z + ps4.w);
    if (__ballot(mnew != mrun) != 0ull) {
        const float alpha = __builtin_amdgcn_exp2f(mrun - mnew);
        lrun *= alpha;
#pragma unroll
        for (int dt = 0; dt < 4; ++dt) o[dt] *= alpha;
    }
    lrun += ps; mrun = mnew;
    float pa[4][4];
#pragma unroll
    for (int kt = 0; kt < 4; ++kt)
#pragma unroll
        for (int j = 0; j < 4; ++j) pa[kt][j] = s[kt][j];
    const bf16x8 pf0 = pack_p(pa[0], pa[1]), pf1 = pack_p(pa[2], pa[3]);
#pragma unroll
    for (int dt = 0; dt < 4; ++dt) {
        o[dt] = __builtin_amdgcn_mfma_f32_16x16x32_bf16(vfr[dt][0], pf0, o[dt], 0, 0, 0); o[dt] = __builtin_amdgcn_mfma_f32_16x16x32_bf16(vfr[dt][1], pf1, o[dt], 0, 0, 0);
    }
}
template <int MODE>
__device__ __forceinline__ void attn_stream(const bf16* K, const bf16* VT, const bf16x8 qf0, const bf16x8 qf1, int t, int p0, int pb, unsigned selm, const float* bias, float cfar, f32x4 (&o)[4],
                                            int qi, int q4, int tid, unsigned char* lds) {
    const int st_hi = pb >> 1;
    const int st_lo = MODE == 1 ? ((pb * 32 - 511 > 0 ? pb * 32 - 511 : 0) >> 6) : 0;
    const int my_lo = MODE == 1 ? ((p0 - 511 > 0 ? p0 - 511 : 0) >> 6) : 0;
    float mrun = NEGF, lrun = 0.f;
#pragma unroll
    for (int dt = 0; dt < 4; ++dt) o[dt] = (f32x4){0.f, 0.f, 0.f, 0.f};
    const int crow = tid >> 3, cch = tid & 7;
    const bf16* kg = K + (size_t)crow * 64 + cch * 8;
    const bf16* vg = VT + (size_t)crow * 2048 + cch * 8;
    const int kdst = crow * AKP + cch * 16;
    const int vdst = 9216 + crow * AKP + ((cch >> 2) * 32 + (cch & 1) * 16 + ((cch & 3) >> 1) * 4) * 2;
    const int koff = qi * AKP + q4 * 16, voff = 9216 + qi * AKP + q4 * 16;
    unsigned char* sb0 = lds + AL_KV0; unsigned char* sb1 = sb0 + KV_STAGE;
#define AT_LOAD(s_, k_, v_) do { k_ = *(const u32x4*)(kg + (size_t)(s_) * 4096); v_ = *(const u32x4*)(vg + (s_) * 64); } while (0)
#define AT_STORE(sb_, k_, v_) do { *(u32x4*)((sb_) + kdst) = k_; *(u32x2*)((sb_) + vdst) = (u32x2){v_.x, v_.y}; *(u32x2*)((sb_) + vdst + 16) = (u32x2){v_.z, v_.w}; } while (0)
#define AT_COMPUTE(sb_, s_) do { bool sel_ = true; if (MODE == 0) sel_ = (selm >> (s_)) & 1u; \
        if ((s_) >= my_lo && (MODE == 1 || __ballot(sel_) != 0ull)) attn_step<MODE>(sb_, s_, qf0, qf1, t, p0, sel_, bias, cfar, o, mrun, lrun, koff, voff, q4); } while (0)
    u32x4 ka, va, kb = {0u, 0u, 0u, 0u}, vb = {0u, 0u, 0u, 0u};
    AT_LOAD(st_lo, ka, va);
    if (st_lo + 1 <= st_hi) AT_LOAD(st_lo + 1, kb, vb);
    AT_STORE(sb0, ka, va);
    LBAR();
    for (int st = st_lo; st <= st_hi; st += 2) {
        if (st + 2 <= st_hi) AT_LOAD(st + 2, ka, va);
        AT_COMPUTE(sb0, st);
        if (st + 1 <= st_hi) AT_STORE(sb1, kb, vb);
        LBAR();
        if (st + 1 > st_hi) break;
        if (st + 3 <= st_hi) AT_LOAD(st + 3, kb, vb);
        AT_COMPUTE(sb1, st + 1);
        if (st + 2 <= st_hi) AT_STORE(sb0, ka, va);
        LBAR();
    }
#undef AT_LOAD
#undef AT_STORE
#undef AT_COMPUTE
    lrun += __shfl_xor(lrun, 16); lrun += __shfl_xor(lrun, 32);
    const float inv = lrun > 0.f ? 1.f / lrun : 0.f;
#pragma unroll
    for (int dt = 0; dt < 4; ++dt) o[dt] *= inv;
}

constexpr int AL_CK = 77824, CKP = 144, AL_CV = AL_CK + 128 * CKP, CVP = 272;
constexpr int AL_BIAS = 0, AL_IMPA = 2048, AL_IMPB = AL_IMPA + 16384, AL_IMPT = AL_IMPB + 16384, AL_SELM = AL_IMPT + 4096;
__device__ __forceinline__ void attn_unit(int bg, int pb, bool build, const bf16* Q, const bf16* KV, const bf16* KCN, const bf16* VCT, const float* GATES, const float* rel_bias, bf16* A, unsigned char* lds) {
    int tid_ = threadIdx.x; OPQ_V(tid_); const int tid = tid_, lane = tid & 63, w = __builtin_amdgcn_readfirstlane(tid >> 6), qi = lane & 15, q4 = lane >> 4;
    const int hl = w & 3, half = w >> 2, b = bg >> 2, g = bg & 3, head = g * 4 + hl;
    const int p0 = pb * 32 + half * 16, t = p0 + qi; const size_t tok = (size_t)b * 2048 + t;
    float* biasT = (float*)(lds + AL_BIAS); float* impA = (float*)(lds + AL_IMPA); float* impB = (float*)(lds + AL_IMPB); float* impT = (float*)(lds + AL_IMPT); unsigned* selw = (unsigned*)(lds + AL_SELM);
    const bf16x8 qf0 = *(const bf16x8*)(Q + tok * 1024 + head * 64 + q4 * 8), qf1 = *(const bf16x8*)(Q + tok * 1024 + head * 64 + 32 + q4 * 8);
    const float g0 = GATES[tok * 48 + head * 3 + 0], g1 = GATES[tok * 48 + head * 3 + 1], g2 = GATES[tok * 48 + head * 3 + 2];
    if (tid < 32) selw[tid] = 0u;
    if (build) {
        const int h_ = tid >> 7, d_ = tid & 127; if (d_ < BIAS_N) biasT[h_ * 128 + d_] = rel_bias[t5_bucket(d_) * 16 + g * 4 + h_] * LOG2E;
#pragma unroll
        for (int i = 0; i < 2; ++i) { const int id = tid + 512 * i, row = id >> 3, ch = id & 7;
            *(u32x4*)(lds + AL_CK + row * CKP + ch * 16) = *(const u32x4*)(KCN + ((size_t)bg * 128 + row) * 64 + ch * 8); }
#pragma unroll
        for (int i = 0; i < 2; ++i) { const int id = tid + 512 * i, row = id >> 4, ch = id & 15;
            *(u32x4*)(lds + AL_CV + row * CVP + ch * 16) = *(const u32x4*)(VCT + ((size_t)bg * 64 + row) * 128 + ch * 8); }
        __syncthreads();
    }
    const float* bias = biasT + hl * 128; const float cfar = bias[BIAS_N - 1];
    f32x4 acc[4];
    {
        const int nst = (2 * pb + 1 + 31) >> 5;
        float pc[4][2][4];
#pragma unroll
        for (int st = 0; st < 4; ++st)
#pragma unroll
            for (int ph = 0; ph < 2; ++ph)
#pragma unroll
                for (int j = 0; j < 4; ++j) pc[st][ph][j] = NEGF;
        float mx = NEGF;
#pragma unroll
        for (int st = 0; st < 4; ++st) if (st < nst) {
#pragma unroll
            for (int ph = 0; ph < 2; ++ph) {
                const bf16* kp = (const bf16*)(lds + AL_CK + (st * 32 + ph * 16 + qi) * CKP) + q4 * 8;
                const bf16x8 a0 = *(const bf16x8*)kp, a1 = *(const bf16x8*)(kp + 32);
                f32x4 s = {0.f, 0.f, 0.f, 0.f};
                s = __builtin_amdgcn_mfma_f32_16x16x32_bf16(a0, qf0, s, 0, 0, 0); s = __builtin_amdgcn_mfma_f32_16x16x32_bf16(a1, qf1, s, 0, 0, 0);
#pragma unroll
                for (int j = 0; j < 4; ++j) {
                    const int c = st * 32 + ph * 16 + q4 * 4 + j, dist = t - (16 * c + 31);
                    const int bi = dist < 0 ? 0 : (dist > BIAS_N - 1 ? BIAS_N - 1 : dist);
                    const float l = s[j] * SC2 + bias[bi];
                    if (dist >= 0) { pc[st][ph][j] = l; mx = fmaxf(mx, l); }
                }
            }
        }
        mx = fmaxf(mx, __shfl_xor(mx, 16)); mx = fmaxf(mx, __shfl_xor(mx, 32));
        float sum = 0.f;
#pragma unroll
        for (int st = 0; st < 4; ++st)
#pragma unroll
            for (int ph = 0; ph < 2; ++ph)
#pragma unroll
                for (int j = 0; j < 4; ++j) { const float p = pc[st][ph][j] > -1e29f ? __builtin_amdgcn_exp2f(pc[st][ph][j] - mx) : 0.f; pc[st][ph][j] = p; sum += p; }
        sum += __shfl_xor(sum, 16); sum += __shfl_xor(sum, 32);
        const float inv = sum > 0.f ? 1.f / sum : 0.f;
        f32x4 oc[4];
#pragma unroll
        for (int dt = 0; dt < 4; ++dt) oc[dt] = (f32x4){0.f, 0.f, 0.f, 0.f};
        const int prow = (hl * 32 + half * 16 + qi) * 32;
#pragma unroll
        for (int st = 0; st < 4; ++st) {
#pragma unroll
            for (int ph = 0; ph < 2; ++ph) {
#pragma unroll
                for (int j = 0; j < 4; ++j) pc[st][ph][j] *= inv;
                const int jj = st * 8 + ph * 4 + q4;
                impA[prow + jj] = pc[st][ph][0] + pc[st][ph][1] + pc[st][ph][2] + 0.5f * pc[st][ph][3];
                impB[prow + jj] = 0.5f * pc[st][ph][3];
            }
            if (st < nst) {
                const bf16x8 pf = pack_p(pc[st][0], pc[st][1]);
#pragma unroll
                for (int dt = 0; dt < 4; ++dt) { const bf16x8 vf = ldv((const bf16*)(lds + AL_CV + (dt * 16 + qi) * CVP) + st * 32 + q4 * 4); oc[dt] = __builtin_amdgcn_mfma_f32_16x16x32_bf16(vf, pf, oc[dt], 0, 0, 0); }
            }
        }
#pragma unroll
        for (int dt = 0; dt < 4; ++dt) acc[dt] = oc[dt] * g0;
    }
    __syncthreads();
    for (int idx = tid; idx < 1024; idx += 512) {
        const int pos = idx >> 5, j = idx & 31; float s = 0.f;
#pragma unroll
        for (int h = 0; h < 4; ++h) s += impA[(h * 32 + pos) * 32 + j] + (j > 0 ? impB[(h * 32 + pos) * 32 + j - 1] : 0.f);
        impT[idx] = s;
    }
    __syncthreads();
    {
        const int cur = pb >> 1, pos = tid >> 4;
        float iv[32];
#pragma unroll
        for (int q = 0; q < 8; ++q) { const f32x4 v4 = *(const f32x4*)(impT + pos * 32 + 4 * q); iv[4 * q] = v4.x; iv[4 * q + 1] = v4.y; iv[4 * q + 2] = v4.z; iv[4 * q + 3] = v4.w; }
        unsigned bits = 0u;
#pragma unroll
        for (int h2 = 0; h2 < 2; ++h2) {
            const int jj = (tid & 15) + 16 * h2;
            bool sel = false;
            if (jj <= cur) {
                if (jj == 0 || jj == cur || jj == cur - 1) sel = true;
                else {
                    float v = 0.f;
#pragma unroll
                    for (int j2 = 0; j2 < 32; ++j2) v = (j2 == jj) ? iv[j2] : v;
                    int cnt = 3;
#pragma unroll
                    for (int j2 = 1; j2 < 30; ++j2) cnt += (j2 <= cur - 2) && (j2 != jj) && ((iv[j2] > v) || (iv[j2] == v && j2 < jj));
                    sel = cnt < 16;
                }
            }
            if (sel) bits |= 1u << jj;
        }
        if (bits) atomicOr(&selw[pos], bits);
    }
    __syncthreads();
    const unsigned selm = selw[half * 16 + qi];
    {
        f32x4 o[4];
        attn_stream<0>(KV + 2 * KV_ELEMS + (size_t)bg * 2048 * 64, KV + 3 * KV_ELEMS + (size_t)bg * 64 * 2048, qf0, qf1, t, p0, pb, selm, bias, cfar, o, qi, q4, tid, lds);
#pragma unroll
        for (int dt = 0; dt < 4; ++dt) acc[dt] += o[dt] * g1;
    }
    {
        f32x4 o[4];
        attn_stream<1>(KV + 4 * KV_ELEMS + (size_t)bg * 2048 * 64, KV + 5 * KV_ELEMS + (size_t)bg * 64 * 2048, qf0, qf1, t, p0, pb, 0u, bias, cfar, o, qi, q4, tid, lds);
#pragma unroll
        for (int dt = 0; dt < 4; ++dt) acc[dt] += o[dt] * g2;
    }
#pragma unroll
    for (int dt = 0; dt < 4; ++dt) {
        u32x2 pk; pk.x = cvtpk(acc[dt][0], acc[dt][1]); pk.y = cvtpk(acc[dt][2], acc[dt][3]);
        *(u32x2*)(A + tok * 1024 + head * 64 + dt * 16 + q4 * 4) = pk;
    }
    __syncthreads();
}

#define GAS __attribute__((address_space(1)))

#define RLX_AGENT __ATOMIC_RELAXED, __HIP_MEMORY_SCOPE_AGENT
#define XB_TMO      128
#define XB_XCNT(j)  (256  + 64 * (j))
#define XB_XSUB(j)  (1280 + 64 * (j))
#define XB_XGEN(j)  (2304 + 64 * (j))
#define XB_TOP      3328
#define XB_TOPGEN   3392
#define XCD_BAR_WORDS 3456
#define XB_SPIN_CAP (1u << 18)

__device__ __forceinline__ unsigned xb_ld(unsigned* p)              { return __hip_atomic_load(p, __ATOMIC_RELAXED, __HIP_MEMORY_SCOPE_AGENT); }
__device__ __forceinline__ unsigned xb_add(unsigned* p, unsigned v) { return __hip_atomic_fetch_add(p, v, __ATOMIC_RELAXED, __HIP_MEMORY_SCOPE_AGENT); }
__device__ __forceinline__ unsigned xb_xcc_id() { return (unsigned)__builtin_amdgcn_s_getreg((3 << 11) | 20) & 0xFu; }
#define XB_SPIN(cond, bar) do { unsigned _sp = 0; while (cond) { __builtin_amdgcn_s_sleep(1); \
    if ((++_sp & 255u) == 0u) { if (xb_ld(&(bar)[XB_TMO])) break; if (_sp > XB_SPIN_CAP) { atomicAdd(&(bar)[XB_TMO], 1u); break; } } } } while (0)

struct XcdBarrier {
    unsigned* bar; unsigned x;
    volatile LAS unsigned* st;
};

__device__ __forceinline__ XcdBarrier xcd_barrier_post(unsigned* bar, volatile LAS unsigned* st) {
    XcdBarrier b; b.bar = bar; b.x = xb_xcc_id(); b.st = st;
    if (threadIdx.x == 0) (void)xb_add(&bar[XB_XCNT(b.x)], 1u);
    return b;
}
__device__ __forceinline__ void xcd_barrier_complete(unsigned* bar, unsigned x, unsigned& nloc, unsigned& nx) {
    const unsigned G = gridDim.x * gridDim.y * gridDim.z;
    unsigned sum, cnt, mine, sp = 0u;
    for (;;) {
        sum = 0u; cnt = 0u; mine = 0u;
#pragma unroll
        for (unsigned j = 0; j < 16; ++j) { const unsigned c = xb_ld(&bar[XB_XCNT(j)]); sum += c; cnt += (c > 0u) ? 1u : 0u; mine = (j == x) ? c : mine; }
        if (sum == G) break;
        __builtin_amdgcn_s_sleep(1);
        if ((++sp & 255u) == 0u) { if (xb_ld(&bar[XB_TMO])) break; if (sp > XB_SPIN_CAP) { atomicAdd(&bar[XB_TMO], 1u); break; } }
    }
    nloc = mine > 0u ? mine : 1u; nx = cnt > 0u ? cnt : 1u;
}

__device__ __forceinline__ void xcd_barrier(const XcdBarrier& b) {
    asm volatile("s_waitcnt vmcnt(0)" ::: "memory");
    __syncthreads();
    if (threadIdx.x == 0) {
        unsigned* bar = b.bar;
        __builtin_amdgcn_s_waitcnt(0);
        unsigned nloc = b.st[0], nx = b.st[1];
        if (nloc == 0u) { xcd_barrier_complete(bar, b.x, nloc, nx); b.st[0] = nloc; b.st[1] = nx; }
        const unsigned old = xb_add(&bar[XB_XSUB(b.x)], 1u);
        const unsigned gen = old / nloc;
        if (old + 1u == (gen + 1u) * nloc) {
            __builtin_amdgcn_fence(__ATOMIC_RELEASE, "agent");
            asm volatile("s_waitcnt vmcnt(0)" ::: "memory");
            const unsigned og = xb_add(&bar[XB_TOP], 1u);
            const unsigned tg = og / nx;
            if (og + 1u == (tg + 1u) * nx) xb_add(&bar[XB_TOPGEN], 1u);
            else XB_SPIN(xb_ld(&bar[XB_TOPGEN]) == tg, bar);
            __builtin_amdgcn_fence(__ATOMIC_ACQUIRE, "agent");
            xb_add(&bar[XB_XGEN(b.x)], 1u);
            asm volatile("s_waitcnt vmcnt(0)" ::: "memory");
        } else {
            XB_SPIN(xb_ld(&bar[XB_XGEN(b.x)]) == gen, bar);
            __builtin_amdgcn_fence(__ATOMIC_ACQUIRE, "agent");
            asm volatile("s_waitcnt vmcnt(0)" ::: "memory");
        }
    }
    __syncthreads();
}

__global__ void __launch_bounds__(512, 2) fwd_megakernel(Args args) {
    extern __shared__ __attribute__((aligned(16))) unsigned char lds[];
    cg::grid_group grid = cg::this_grid();
    const int G = gridDim.x, bx = blockIdx.x;
    PG8_LAS unsigned char* ring = (PG8_LAS unsigned char*)lds;
    { volatile LAS unsigned* bst = (volatile LAS unsigned*)(lds_base() + (LDS_BYTES - 64));
      if (threadIdx.x < 2) bst[threadIdx.x] = 0u;
      if (bx == 0) { unsigned* barw = (unsigned*)(args.ws + WS_BAR); for (int i = threadIdx.x; i < BARW_TOTAL; i += 512) barw[i] = 0u; } }

    {
        unsigned char* ws = args.ws;
        int tid_ = threadIdx.x; OPQ_V(tid_); const int tid = tid_, lane = tid & 63, wave = __builtin_amdgcn_readfirstlane(tid >> 6);
        const int gw = bx * 8 + wave, NGW = G * 8;
        LAS float* scr = (LAS float*)((LAS unsigned char*)lds + wave * 16640);
#pragma unroll 1
        for (int l = 0; l < NLAYER; ++l) {
            unsigned char* lw = ws + (size_t)l * LW_BYTES;
            conv_set(CV_ARGS(args), ws, l, l == 0 ? (CV_GU1 | CV_D1 | CV_WIN) : CV_D1, scr, gw, NGW, lane);
            { const float* sw = args.in[18] + (size_t)l * 8 * 128 * 128; bf16* dw = (bf16*)(lw + LW_SGW);
              for (int i = bx * 512 + tid; i < 8 * 128 * 128; i += G * 512) { const int tt = (i >> 7) & 127, ss = i & 127; dw[i] = ss <= tt ? f2bf(sw[i]) : (bf16)0; } }
            { float* par = (float*)(lw + LW_PAR);
              for (int i = bx * 512 + tid; i < PAR_FLOATS; i += G * 512) {
                  float v;
                  if (i < PAR_KN) v = args.in[8][l * 64 + i];
                  else if (i < PAR_SGG) v = args.in[9][l * 192 + i - PAR_KN];
                  else if (i < PAR_SGB) v = args.in[16][l * 1024 + i - PAR_SGG];
                  else if (i < PAR_SGBS) v = args.in[17][l * 1024 + i - PAR_SGB];
                  else if (i < PAR_N1) v = args.in[19][l * 1024 + i - PAR_SGBS];
                  else if (i < PAR_NM) v = args.in[2][l * 2048 + i - PAR_N1];
                  else if (i < PAR_N2) v = args.in[6][l * 2048 + i - PAR_NM];
                  else if (i < PAR_RELB) v = args.in[23][l * 2048 + i - PAR_N2];
                  else v = args.in[1][i - PAR_RELB];
                  par[i] = v;
              } }
        }
        __syncthreads();
        for (int it = bx; it < 64; it += G) {
            const int l = it >> 5, isv = (it >> 4) & 1, ng = it & 15, col = tid & 15, sl = tid >> 4;
            const float* pos = args.in[isv ? 11 : 10] + (size_t)l * 2048 + sl * 64; const float* w1 = args.in[isv ? 14 : 12] + (size_t)l * 2048 * 256 + (size_t)sl * 64 * 256 + ng * 16 + col;
            float a = 0.f;
#pragma unroll 16
            for (int k = 0; k < 64; ++k) a += pos[k] * w1[(size_t)k * 256];
            float* part = (float*)lds; part[sl * 16 + col] = a;
            __syncthreads();
            if (tid < 16) { float s = 0.f;
#pragma unroll
                for (int s2 = 0; s2 < 32; ++s2) s += part[s2 * 16 + tid];
                ((float*)(ws + (size_t)l * LW_BYTES + LW_B1))[isv * 256 + ng * 16 + tid] = s; }
            __syncthreads();
        }
        for (int m = gw; m < M; m += NGW) prep_row(args.in[0] + (size_t)m * D, (bf16*)(ws + WS_H) + (size_t)m * D, (bf16*)(ws + WS_L) + (size_t)m * D, (float*)(ws + WS_SS) + (size_t)m * 8, lane);
    }
    grid.sync();
    (void)xcd_barrier_post((unsigned*)(args.ws + WS_BAR), (volatile LAS unsigned*)(lds_base() + (LDS_BYTES - 64)));

#pragma unroll 1
    for (int step = 0; step < 9 * NLAYER; ++step) {
        const int l = step / 9, k = step - l * 9;
        unsigned char* ws = args.ws; OPQ_P(ws); unsigned char* lw = ws + (size_t)l * LW_BYTES;
        if (threadIdx.x < 8) ((LAS int*)(lds_base() + LDS_RSTAG))[threadIdx.x] = 0;
        if (k == 0 || k == 7) {
            pg8::Gemm g{(const bf16*)(ws + WS_H), (const bf16*)(lw + (k == 7 ? LW_GU2 : LW_GU1)), M, 2 * FF, D, D}; pg8::StaticOrder So; So.init(M, 2 * FF, G, bx);
            EpiSwiGLU E{ws};
            pg8::gemm_phase<EpiSwiGLU, pg8::StaticOrder, true, true>(ring, g, So, E);
        } else if (k == 1 || k == 8 || k == 6) {
            const bool isout = k == 6;
            pg8::Gemm g{(const bf16*)(ws + (isout ? WS_MRG : WS_HFF)), (const bf16*)(lw + (isout ? LW_O : (k == 8 ? LW_D2 : LW_D1))), M, D, isout ? D : FF, isout ? D : FF}; pg8::StaticOrder So; So.init(M, D, G, bx);
            EpiResid E{args.out, ws, isout ? 1.0f : 0.5f, step == 9 * NLAYER - 1 ? 1 : 0};
            pg8::gemm_phase<EpiResid, pg8::StaticOrder, true, true>(ring, g, So, E);
        } else if (k == 2) {
            pg8::Gemm g{(const bf16*)(ws + WS_H), (const bf16*)(lw + LW_IN), M, INP, D, D}; pg8::StaticOrder So; So.init(M, INP, G, bx);
            EpiIn E{ws, l};
            pg8::gemm_phase<EpiIn, pg8::StaticOrder, true, true>(ring, g, So, E);
        } else if (k == 3) {
            const float* par = (const float*)(lw + LW_PAR);
            if (G == 256) cs_pair(bx, bx, bx + 256, (const bf16*)(ws + WS_KV), (const bf16*)(lw + LW_C1K), (const bf16*)(lw + LW_C1V), (const bf16*)(lw + LW_C2K), (const bf16*)(lw + LW_C2V), (const float*)(lw + LW_B1),
                                  par + PAR_KN, (bf16*)(ws + WS_KCN), (bf16*)(ws + WS_VCT), (const bf16*)(ws + WS_U), (const bf16*)(ws + WS_V), (const float*)(ws + WS_VSTAT), par + PAR_SGG, par + PAR_SGB,
                                  (const bf16*)(lw + LW_SGW), par + PAR_SGBS, (bf16*)(ws + WS_SG), lds);
            else
            for (int u = bx; u < 768; u += G) {
                if (u < 256) compress_unit(u, (const bf16*)(ws + WS_KV), (const bf16*)(lw + LW_C1K), (const bf16*)(lw + LW_C1V), (const bf16*)(lw + LW_C2K), (const bf16*)(lw + LW_C2V), (const float*)(lw + LW_B1),
                                           par + PAR_KN, (bf16*)(ws + WS_KCN), (bf16*)(ws + WS_VCT), lds);
                else sgu_unit(u - 256, (const bf16*)(ws + WS_U), (const bf16*)(ws + WS_V), (const float*)(ws + WS_VSTAT), par + PAR_SGG, par + PAR_SGB,
                              (const bf16*)(lw + LW_SGW), par + PAR_SGBS, (bf16*)(ws + WS_SG), lds);
            }
        } else if (k == 4) {
            const float* par = (const float*)(lw + LW_PAR);
            int last_bg = -1;
            for (int u = bx; u < 1024; u += G) {
                const int r = u >> 8, wq = u & 255, slot = wq >> 3, i = slot & 15, bg = (wq & 7) * 2 + (slot >> 4);
                const int pb = r == 0 ? 63 - i : (r == 1 ? 32 + i : (r == 2 ? 31 - i : i));
                const bool build = bg != last_bg; last_bg = bg;
                attn_unit(bg, pb, build, (const bf16*)(ws + WS_Q), (const bf16*)(ws + WS_KV), (const bf16*)(ws + WS_KCN), (const bf16*)(ws + WS_VCT), (const float*)(ws + WS_GATES), par + PAR_RELB, (bf16*)(ws + WS_A), lds);
            }
            __syncthreads();
        } else {
            pg8::Gemm g{(const bf16*)(ws + WS_SG), (const bf16*)(lw + LW_PS), M, D, 1024, 1024, (const bf16*)(ws + WS_A), (const bf16*)(lw + LW_PN)};
            pg8::TwoKinds S2; S2.so.init(M, D, G, bx);
            EpiTM E{ws};
            pg8::gemm_phase<EpiTM, pg8::TwoKinds, true, true>(ring, g, S2, E);
        }
        {
            unsigned tmask = 0u; int tl = l;
            if (k == 0) tmask = l == 0 ? (CV_SMALL | CV_D2) : (CV_SMALL | CV_WIN);
            else if (k == 2) tmask = CV_GU2;
            else if (k == 7) { if (l == 0) { tl = 1; tmask = CV_GU1; } else tmask = CV_D2; }
            if (tmask) {
                const int nleft = ((M / 256) * ((k == 2 ? INP : 2 * FF) / 256)) % G;
                if (bx >= nleft) {
                    __syncthreads();
                    int tid_ = threadIdx.x; OPQ_V(tid_); const int lane = tid_ & 63, wave = __builtin_amdgcn_readfirstlane(tid_ >> 6);
                    LAS float* scr = (LAS float*)(lds_base() + wave * 16640);
                    unsigned char* ws2 = args.ws; OPQ_P(ws2);
                    conv_set(CV_ARGS(args), ws2, tl, tmask, scr, (bx - nleft) * 8 + wave, (G - nleft) * 8, lane);
                }
            }
        }
        if (step < 9 * NLAYER - 1) { XcdBarrier xb_; xb_.bar = (unsigned*)(args.ws + WS_BAR); xb_.x = xb_xcc_id(); xb_.st = (volatile LAS unsigned*)(lds_base() + (LDS_BYTES - 64)); xcd_barrier(xb_); }
    }
}

extern "C" void kernel_launch(void* const* d_in, const int* in_sizes, int n_in, void* d_out, int out_size, void* d_ws, size_t ws_size, hipStream_t stream) {
    static int grid = 0;
    if (grid == 0) {
        if (n_in != 27 || out_size != M * D || ws_size < WS_END) { fprintf(stderr, "kernel_launch: unexpected problem (n_in %d out %d ws %zu need %zu)\n", n_in, out_size, ws_size, (size_t)WS_END); grid = -1; return; }
        int dev = 0, cus = 0, per_cu = 0;
        (void)hipGetDevice(&dev);
        (void)hipDeviceGetAttribute(&cus, hipDeviceAttributeMultiprocessorCount, dev);
        (void)hipFuncSetAttribute((const void*)fwd_megakernel, hipFuncAttributeMaxDynamicSharedMemorySize, LDS_BYTES);
        (void)hipOccupancyMaxActiveBlocksPerMultiprocessor(&per_cu, (const void*)fwd_megakernel, 512, LDS_BYTES);
        if (per_cu < 1) per_cu = 1;
        grid = cus * per_cu;
        fprintf(stderr, "kernel_launch: grid %d (cus %d x %d), ws %zu need %zu\n", grid, cus, per_cu, ws_size, (size_t)WS_END);
    }
    if (grid < 0) return;
    Args a{};
    for (int i = 0; i < 27; ++i) a.in[i] = (const float*)d_in[i];
    a.out = (float*)d_out; a.ws = (unsigned char*)d_ws;
    void* kargs[] = {&a};
    hipError_t e = hipLaunchCooperativeKernel((const void*)fwd_megakernel, dim3(grid), dim3(512), kargs, LDS_BYTES, stream);
    if (e != hipSuccess) fprintf(stderr, "kernel_launch: cooperative launch failed: %s (grid %d)\n", hipGetErrorString(e), grid);
}
```
